# Optimizing an MI355X kernel written in HIP

```python
import math
import jax
import jax.numpy as jnp
from jax import lax
import numpy as np

D_MODEL = 1024
BATCH = 16
SEQ = 4096
DEPTH = 1

CHUNK = 64
Q_BLOCK = 128
EPS = 1e-6
NEG_INF = -1e30

GLA_HEADS = 4
GLA_HEAD_K = 64
GLA_HEAD_V = 128
GLA_K = GLA_HEADS * GLA_HEAD_K
GLA_V = GLA_HEADS * GLA_HEAD_V
GLA_LOW_RANK = 16
GLA_TAU = 16.0

DIFF_HEADS = 4
DIFF_HEAD_QK = 64
DIFF_HEAD_V = 2 * DIFF_HEAD_QK
DIFF_QK = DIFF_HEADS * 2 * DIFF_HEAD_QK
DIFF_V = DIFF_HEADS * DIFF_HEAD_V

FFN_HIDDEN = ((-(-8 * D_MODEL // 3) + 255) // 256) * 256
N_MOD = 6

IN_SIZES = (GLA_K, GLA_K, GLA_V, GLA_V, GLA_LOW_RANK, DIFF_QK, DIFF_QK, DIFF_V, D_MODEL, D_MODEL)
IN_COLS = sum(IN_SIZES)

kernel_name = "hybrid_gla_diffattn_adaln_block"


def _rmsnorm(x, g):
    xf = x.astype(jnp.float32)
    y = xf * lax.rsqrt(jnp.mean(xf * xf, axis=-1, keepdims=True) + EPS)
    return (y * g.astype(jnp.float32)).astype(x.dtype)


def _split_heads(t, n_heads):
    b, s, w = t.shape
    return t.reshape(b, s, n_heads, w // n_heads).transpose(0, 2, 1, 3)


def _merge_heads(t):
    b, h, s, d = t.shape
    return t.transpose(0, 2, 1, 3).reshape(b, s, h * d)


def _gla_chunked(q, k, v, log_alpha):
    b, h, s, dk = q.shape
    dv = v.shape[-1]
    n = s // CHUNK
    f32 = jnp.float32
    qf = q.astype(f32).reshape(b, h, n, CHUNK, dk)
    kf = k.astype(f32).reshape(b, h, n, CHUNK, dk)
    vf = v.astype(f32).reshape(b, h, n, CHUNK, dv)
    cum = jnp.cumsum(log_alpha.astype(f32).reshape(b, h, n, CHUNK, dk), axis=3)
    cum_last = cum[:, :, :, -1:, :]
    q_fwd = qf * jnp.exp(cum)
    k_fwd = kf * jnp.exp(-cum)
    q_bwd = qf * jnp.exp(-cum)
    k_bwd = kf * jnp.exp(cum)
    pos = jnp.arange(CHUNK)
    lower = pos[:, None] >= pos[None, :]
    a_intra = jnp.where(lower,
                        jnp.einsum('bhnld,bhnmd->bhnlm', q_fwd, k_fwd),
                        jnp.einsum('bhnld,bhnmd->bhnlm', q_bwd, k_bwd))
    o_intra = jnp.einsum('bhnlm,bhnmv->bhnlv', a_intra, vf)
    chunk_kv = jnp.einsum('bhnld,bhnlv->bhndv', kf * jnp.exp(cum_last - cum), vf)
    chunk_decay = jnp.exp(cum_last[:, :, :, 0, :])

    def step(state, inp):
        kv_c, dec_c = inp
        return dec_c[..., None] * state + kv_c, state

    _, states = lax.scan(step, jnp.zeros((b, h, dk, dv), f32),
                         (jnp.moveaxis(chunk_kv, 2, 0), jnp.moveaxis(chunk_decay, 2, 0)))
    states = jnp.moveaxis(states, 0, 2)
    o_inter = jnp.einsum('bhnld,bhndv->bhnlv', q_fwd, states)
    return (o_intra + o_inter).reshape(b, h, s, dv).astype(v.dtype)


def _diff_attention(q, k, v, lam):
    b, h, s, _, dh = q.shape
    n_blk = s // Q_BLOCK
    scale = dh ** -0.5
    key_chunk = jnp.arange(s) // CHUNK
    q_blocks = jnp.moveaxis(q.reshape(b, h, n_blk, Q_BLOCK, 2, dh), 2, 0)

    def one_block(args):
        q_blk, blk = args
        q_chunk = (blk * Q_BLOCK + jnp.arange(Q_BLOCK)) // CHUNK
        visible = key_chunk[None, :] <= q_chunk[:, None]
        scores = jnp.einsum('bhqmd,bhkmd->bhmqk', q_blk, k).astype(jnp.float32) * scale
        probs = jax.nn.softmax(jnp.where(visible, scores, NEG_INF), axis=-1)
        weights = probs[:, :, 0] - lam * probs[:, :, 1]
        return jnp.einsum('bhqk,bhkd->bhqd', weights.astype(v.dtype), v)

    out = lax.map(one_block, (q_blocks, jnp.arange(n_blk)))
    return jnp.moveaxis(out, 0, 2).reshape(b, h, s, v.shape[-1])


def setup_inputs(seed: int = 0) -> dict:
    key = jax.random.key(seed)
    ks = jax.random.split(key, 24)
    f32 = jnp.float32
    nrm = lambda k, shape, s: jax.random.normal(k, shape, f32) * s
    gain = lambda k, shape: 1.0 + 0.01 * jax.random.normal(k, shape, f32)
    return {
        "x": nrm(ks[0], (BATCH, SEQ, D_MODEL), 1.0),
        "c": nrm(ks[1], (BATCH, D_MODEL), 1.0),
        "w_ada": nrm(ks[2], (DEPTH, D_MODEL, N_MOD * D_MODEL), 0.5 * D_MODEL ** -0.5),
        "b_ada": nrm(ks[3], (DEPTH, N_MOD * D_MODEL), 0.01),
        "g_mix": gain(ks[4], (DEPTH, D_MODEL)),
        "w_in": nrm(ks[5], (DEPTH, D_MODEL, IN_COLS), D_MODEL ** -0.5),
        "w_alpha_up": nrm(ks[6], (DEPTH, GLA_LOW_RANK, GLA_K), GLA_LOW_RANK ** -0.5),
        "b_alpha": nrm(ks[7], (DEPTH, GLA_K), 0.1),
        "g_gla_out": gain(ks[8], (DEPTH, GLA_HEAD_V)),
        "g_diff_q": gain(ks[9], (DEPTH, DIFF_HEAD_QK)),
        "g_diff_k": gain(ks[10], (DEPTH, DIFF_HEAD_QK)),
        "lambda_q1": nrm(ks[11], (DEPTH, DIFF_HEAD_QK), 0.1),
        "lambda_k1": nrm(ks[12], (DEPTH, DIFF_HEAD_QK), 0.1),
        "lambda_q2": nrm(ks[13], (DEPTH, DIFF_HEAD_QK), 0.1),
        "lambda_k2": nrm(ks[14], (DEPTH, DIFF_HEAD_QK), 0.1),
        "g_diff_out": gain(ks[15], (DEPTH, DIFF_HEAD_V)),
        "w_br_gla": nrm(ks[16], (DEPTH, GLA_V, D_MODEL), GLA_V ** -0.5),
        "w_br_diff": nrm(ks[17], (DEPTH, DIFF_V, D_MODEL), DIFF_V ** -0.5),
        "w_out": nrm(ks[18], (DEPTH, D_MODEL, D_MODEL), D_MODEL ** -0.5),
        "g_ffn": gain(ks[19], (DEPTH, D_MODEL)),
        "w_ffn_in": nrm(ks[20], (DEPTH, D_MODEL, 2 * FFN_HIDDEN), D_MODEL ** -0.5),
        "w_ffn_out": nrm(ks[21], (DEPTH, FFN_HIDDEN, D_MODEL), FFN_HIDDEN ** -0.5),
    }


def reference(x, c, w_ada, b_ada, g_mix, w_in, w_alpha_up, b_alpha, g_gla_out,
              g_diff_q, g_diff_k, lambda_q1, lambda_k1, lambda_q2, lambda_k2, g_diff_out,
              w_br_gla, w_br_diff, w_out, g_ffn, w_ffn_in, w_ffn_out):
    b, s, _ = x.shape
    offsets = np.cumsum(IN_SIZES)[:-1].tolist()
    c_act = jax.nn.silu(c)
    for l in range(DEPTH):
        lambda_init = 0.8 - 0.6 * math.exp(-0.3 * l)
        mod = c_act @ w_ada[l] + b_ada[l]
        sh_m, sc_m, gt_m, sh_f, sc_f, gt_f = [m[:, None, :] for m in jnp.split(mod, N_MOD, axis=-1)]

        h = _rmsnorm(x, g_mix[l]) * (1.0 + sc_m) + sh_m
        proj = h @ w_in[l]
        gq, gk, gv, gr, ga, dq, dk, dv, pre_g_gla, pre_g_diff = jnp.split(proj, offsets, axis=-1)

        log_alpha = jax.nn.log_sigmoid((ga @ w_alpha_up[l] + b_alpha[l]).astype(jnp.float32)) / GLA_TAU
        o_gla = _gla_chunked(_split_heads(gq, GLA_HEADS) * (GLA_HEAD_K ** -0.5),
                             _split_heads(gk, GLA_HEADS),
                             _split_heads(gv, GLA_HEADS),
                             _split_heads(log_alpha, GLA_HEADS))
        o_gla = _merge_heads(_rmsnorm(o_gla, g_gla_out[l])) * jax.nn.silu(gr)
        y_gla = o_gla @ w_br_gla[l]

        q = _rmsnorm(dq.reshape(b, s, DIFF_HEADS, 2, DIFF_HEAD_QK), g_diff_q[l]).transpose(0, 2, 1, 3, 4)
        k = _rmsnorm(dk.reshape(b, s, DIFF_HEADS, 2, DIFF_HEAD_QK), g_diff_k[l]).transpose(0, 2, 1, 3, 4)
        v = _split_heads(dv, DIFF_HEADS)
        lam = (jnp.exp(jnp.sum(lambda_q1[l].astype(jnp.float32) * lambda_k1[l].astype(jnp.float32)))
               - jnp.exp(jnp.sum(lambda_q2[l].astype(jnp.float32) * lambda_k2[l].astype(jnp.float32)))
               + lambda_init)
        o_diff = _diff_attention(q, k, v, lam)
        o_diff = _merge_heads(_rmsnorm(o_diff, g_diff_out[l]) * (1.0 - lambda_init))
        y_diff = o_diff @ w_br_diff[l]

        mixed = jax.nn.sigmoid(pre_g_gla) * y_gla + jax.nn.sigmoid(pre_g_diff) * y_diff
        x = x + gt_m * (mixed @ w_out[l])

        h2 = _rmsnorm(x, g_ffn[l]) * (1.0 + sc_f) + sh_f
        gate, up = jnp.split(h2 @ w_ffn_in[l], 2, axis=-1)
        x = x + gt_f * ((jax.nn.silu(gate) * up) @ w_ffn_out[l])
    return x
```

```cpp
#include <hip/hip_runtime.h>
#include <hip/hip_cooperative_groups.h>
#include <cstdio>
#include <cstdint>
namespace cg = cooperative_groups;

#define LAS __attribute__((address_space(3)))
typedef unsigned short bf16_t;
typedef short bf16x8 __attribute__((ext_vector_type(8)));
typedef float f32x4 __attribute__((ext_vector_type(4)));
typedef float f32x16 __attribute__((ext_vector_type(16)));
typedef float f32x2 __attribute__((ext_vector_type(2)));
typedef unsigned u32x4 __attribute__((ext_vector_type(4)));
typedef unsigned u32x2 __attribute__((ext_vector_type(2)));
typedef __bf16 bf16x2_t __attribute__((ext_vector_type(2)));

__device__ __forceinline__ unsigned pk2(float lo, float hi) { f32x2 v = {lo, hi}; bf16x2_t b = __builtin_convertvector(v, bf16x2_t); return __builtin_bit_cast(unsigned, b); }
__device__ __forceinline__ float bf_lo(unsigned u) { return __uint_as_float(u << 16); }
__device__ __forceinline__ float bf_hi(unsigned u) { return __uint_as_float(u & 0xffff0000u); }
__device__ __forceinline__ float bf1(bf16_t u) { return __uint_as_float(((unsigned)u) << 16); }
__device__ __forceinline__ float sigmoidf_(float x) { return __builtin_amdgcn_rcpf(1.0f + __builtin_amdgcn_exp2f(x * -1.4426950408889634f)); }
__device__ __forceinline__ float siluf_(float x) { return x * __builtin_amdgcn_rcpf(1.0f + __builtin_amdgcn_exp2f(x * -1.4426950408889634f)); }
__device__ __forceinline__ int tid_fresh() { int t = threadIdx.x; asm volatile("" : "+v"(t)); return t; }
__device__ __forceinline__ int crow(int r, int hi) { return (r & 3) + 8 * (r >> 2) + 4 * hi; }
__device__ __forceinline__ float wave_sum(float v) {
#pragma unroll
    for (int o = 1; o < 64; o <<= 1) v += __shfl_xor(v, o);
    return v;
}

constexpr int BATCH = 16, SEQ = 4096, DM = 1024, MTOK = BATCH * SEQ;
constexpr int NMOD = 6 * DM;
constexpr int INCOLS = 5136;
constexpr int NA = 4352;
constexpr int FFH = 2816;
constexpr float EPS = 1e-6f;
constexpr float LOG2E = 1.4426950408889634f;
constexpr int C_GQ = 0, C_GK = 256, C_GV = 512, C_GR = 1024, C_GA = 1536, C_DQ = 1552, C_DK = 2064, C_DV = 2576, C_G1 = 3088, C_G2 = 4112;

constexpr size_t MiB = 1u << 20;
constexpr size_t WS_MOD = 0;
constexpr size_t WS_MISC = 512 * 1024;
constexpr size_t WS_BAR = 768 * 1024;
constexpr size_t WS_WA = 1 * MiB;
constexpr size_t WS_WV = 10 * MiB;
constexpr size_t WS_WBG = 12 * MiB;
constexpr size_t WS_WBD = 13 * MiB;
constexpr size_t WS_WO = 14 * MiB;
constexpr size_t WS_WF1 = 16 * MiB;
constexpr size_t WS_WF2 = 27 * MiB;
constexpr size_t WS_H = 40 * MiB;
constexpr size_t WS_GQ = 168 * MiB;
constexpr size_t WS_GK = 200 * MiB;
constexpr size_t WS_LA = 232 * MiB;
constexpr size_t WS_GR = 296 * MiB;
constexpr size_t WS_DQ = 360 * MiB;
constexpr size_t WS_DK = 424 * MiB;
constexpr size_t WS_G1 = 488 * MiB;
constexpr size_t WS_G2 = 616 * MiB;
constexpr size_t WS_VT = 744 * MiB;
constexpr size_t WS_OG = 872 * MiB;
constexpr size_t WS_OD = 936 * MiB;
constexpr size_t WS_X1B = 872 * MiB;
constexpr size_t WS_MIX = 168 * MiB;
constexpr size_t WS_ACT = 296 * MiB;
constexpr size_t WS_END = 1000 * MiB;

constexpr int LDS_BYTES = 147456;

namespace pg8 {
constexpr int BM = 256, BK = 64, HALF = 128, HTB = HALF * BK * 2, STAGE_BYTES = 8 * HTB, NXCD = 8, WGM = 8;
__host__ __device__ __forceinline__ int lds_byte(int r, int c) { const int st = (r >> 4) * 2 + (c >> 5), rr = r & 15, cc = c & 31, ob = rr * 64 + cc * 2; return st * 1024 + (ob ^ (((ob >> 9) & 1) << 5)); }
__host__ __device__ __forceinline__ void stage_rc(int b, int& R, int& C) { const int st = b / 1024, sb = b % 1024, swz = sb ^ (((sb >> 9) & 1) << 5); R = (st >> 1) * 16 + swz / 64; C = (st & 1) * 32 + (swz % 64) / 2; }
__host__ __device__ __forceinline__ int perm32(int rho) { const int n = rho >> 4, i = rho & 15; return 8 * (i >> 2) + 4 * n + (i & 3); }
__host__ __device__ __forceinline__ int permV(int rho) { const int n = rho >> 4, fq = (rho >> 2) & 3, j = rho & 3; return 16 * (fq >> 1) + 8 * n + 4 * (fq & 1) + j; }

struct Unit { int pm, pn, seg; };
struct Gemm { const bf16_t* A0; const bf16_t* A1; const bf16_t* B0; const bf16_t* B1; int M, N, K; };

template <int NM, int NN, int DUALV>
struct StaticOrder {
    int G, c;
    __device__ void init(int G_, int c_) { G = G_; c = c_; }
    __device__ bool next(int i, Unit& u) const {
        constexpr int nwg = NM * NN, q = nwg / NXCD, r = nwg % NXCD, nig = WGM * NN;
        const int it = DUALV ? (i >> 1) : i;
        const long L = (long)it * G + c; if (L >= nwg) return false;
        int wgid = (int)L; { const int xcd = wgid % NXCD, off = wgid / NXCD; wgid = (xcd < r ? xcd * (q + 1) : r * (q + 1) + (xcd - r) * q) + off; }
        const int gid = wgid / nig, fm = gid * WGM, rem = wgid % nig;
        if constexpr (NM % WGM == 0) { u.pm = fm + (rem % WGM); u.pn = rem / WGM; }
        else { const int gsz = (NM - fm) < WGM ? (NM - fm) : WGM; u.pm = fm + (rem % gsz); u.pn = rem / gsz; }
        u.seg = DUALV ? (i & 1) : 0; return true;
    }
};

template <class Epi, class Sched, bool ALIGN_EPI, bool SP2>
__device__ __forceinline__ void gemm_phase(LAS unsigned char* lds, const Gemm g, const Sched& S, const Epi& E) {
    const int tid = tid_fresh(), wid = __builtin_amdgcn_readfirstlane(tid >> 6), lane = tid & 63, wr = wid >> 2, wc = wid & 3, fr = lane & 15, fq = lane >> 4;
    const int K = g.K, nt = K / BK;
    unsigned voffA[2], voffB[2];
#pragma unroll
    for (int i = 0; i < 2; ++i) { int R, C; stage_rc(tid * 16 + i * 8192, R, C); const int Rb = (Epi::PERM == 2) ? ((R & ~31) + permV(R & 31)) : (Epi::PERM == 1) ? ((R & ~31) + perm32(R & 31)) : R;
        voffA[i] = (unsigned)(R * K + C) * 2u; voffB[i] = (unsigned)(Rb * K + C) * 2u; }
    const size_t kstep = (size_t)(BK * 2);
    const size_t hstep = (size_t)HALF * K * 2;
    const size_t tstep = 2 * hstep;
    const unsigned ldsw = (unsigned)wid * 1024u;
    const int aoff = lds_byte(wr * 64 + fr, fq * 8), boff = lds_byte(wc * 32 + fr, fq * 8);
#define PG8_SA(b, h) (((b) * 2 + (h)) * HTB)
#define PG8_SB(b, h) ((4 + (b) * 2 + (h)) * HTB)
#define PG8_STAGE(bufoff, gbase, voff) do { _Pragma("unroll") for (int _i = 0; _i < 2; ++_i) \
        __builtin_amdgcn_global_load_lds((const unsigned*)((const char*)(gbase) + (voff)[_i]), (LAS unsigned*)(lds + (bufoff) + ldsw + _i * 8192), 16, 0, 0); } while (0)
#define PG8_LDA(dst, b, h) do { _Pragma("unroll") for (int m = 0; m < 4; ++m) _Pragma("unroll") for (int k = 0; k < 2; ++k) dst[m][k] = *(const LAS bf16x8*)(lds + PG8_SA(b, h) + aoff + m * 2048 + k * 1024); } while (0)
#define PG8_LDB(dst, b, h) do { _Pragma("unroll") for (int n = 0; n < 2; ++n) _Pragma("unroll") for (int k = 0; k < 2; ++k) dst[n][k] = *(const LAS bf16x8*)(lds + PG8_SB(b, h) + boff + n * 2048 + k * 1024); } while (0)
#define PG8_MMA(ai, bj, At, Bt) do { __builtin_amdgcn_s_setprio(1); _Pragma("unroll") for (int m = 0; m < 4; ++m) _Pragma("unroll") for (int n = 0; n < 2; ++n) _Pragma("unroll") for (int k = 0; k < 2; ++k) \
        acc[ai][bj][m][n] = __builtin_amdgcn_mfma_f32_16x16x32_bf16(Bt[n][k], At[m][k], acc[ai][bj][m][n], 0, 0, 0); __builtin_amdgcn_s_setprio(0); } while (0)
#define PG8_WAIT_V(n) asm volatile("s_waitcnt vmcnt(" #n ")" ::: "memory")
#define PG8_WAIT_L(n) asm volatile("s_waitcnt lgkmcnt(" #n ")" ::: "memory")
#define PG8_BAR __builtin_amdgcn_s_barrier()
#define PG8_SCHED __builtin_amdgcn_sched_barrier(0)
    Unit cur, nxt; int ui = 0;
    if (!S.next(0, cur)) return;
    f32x4 acc[2][2][4][2];
#pragma unroll
    for (int a = 0; a < 2; ++a)
#pragma unroll
        for (int b = 0; b < 2; ++b)
#pragma unroll
            for (int m = 0; m < 4; ++m)
#pragma unroll
                for (int n = 0; n < 2; ++n) acc[a][b][m][n] = (f32x4){0.f, 0.f, 0.f, 0.f};
    bf16x8 At[4][2], B0[2][2], B1[2][2];
    const char* cA = (const char*)(cur.seg ? g.A1 : g.A0) + (size_t)cur.pm * tstep; const char* cB = (const char*)(cur.seg ? g.B1 : g.B0) + (size_t)cur.pn * tstep;
    if constexpr (SP2) {
        PG8_STAGE(PG8_SB(0, 0), cB, voffB); PG8_STAGE(PG8_SB(0, 1), cB + hstep, voffB); PG8_STAGE(PG8_SA(0, 0), cA, voffA); PG8_STAGE(PG8_SA(0, 1), cA + hstep, voffA);
        if (wr == 1) PG8_BAR;
        PG8_WAIT_V(2); PG8_BAR;
        PG8_STAGE(PG8_SB(1, 0), cB + kstep, voffB); PG8_STAGE(PG8_SA(1, 0), cA + kstep, voffA); PG8_STAGE(PG8_SB(1, 1), cB + hstep + kstep, voffB);
        PG8_WAIT_V(6); PG8_BAR;
    } else {
        PG8_STAGE(PG8_SB(0, 0), cB, voffB); PG8_STAGE(PG8_SA(0, 0), cA, voffA); PG8_STAGE(PG8_SB(0, 1), cB + hstep, voffB); PG8_STAGE(PG8_SA(0, 1), cA + hstep, voffA);
        if (wr == 1) PG8_BAR;
        PG8_WAIT_V(4); PG8_BAR;
        PG8_STAGE(PG8_SB(1, 0), cB + kstep, voffB); PG8_STAGE(PG8_SA(1, 0), cA + kstep, voffA); PG8_STAGE(PG8_SB(1, 1), cB + hstep + kstep, voffB);
        PG8_WAIT_V(6); PG8_BAR;
    }
    for (;;) {
        const bool has_next = S.next(ui + 1, nxt);
        const char* nA = has_next ? (const char*)(nxt.seg ? g.A1 : g.A0) + (size_t)nxt.pm * tstep : cA; const char* nB = has_next ? (const char*)(nxt.seg ? g.B1 : g.B0) + (size_t)nxt.pn * tstep : cB;
        for (int t = 0; t < nt; t += 2) {
            const bool last = (t == nt - 2);
            const char* a1 = cA + (size_t)(t + 1) * kstep;
            const char* a2 = last ? nA : cA + (size_t)(t + 2) * kstep; const char* b2 = last ? nB : cB + (size_t)(t + 2) * kstep;
            const char* a3 = a2 + kstep; const char* b3 = b2 + kstep;
            if constexpr (SP2) {
            PG8_LDB(B0, 0, 0); PG8_LDB(B1, 0, 1); PG8_SCHED; PG8_LDA(At, 0, 0); PG8_STAGE(PG8_SA(1, 1), a1 + hstep, voffA);
            PG8_WAIT_V(8); PG8_WAIT_L(0); PG8_BAR; PG8_MMA(0, 0, At, B0); PG8_MMA(0, 1, At, B1); PG8_BAR; PG8_SCHED;
            PG8_LDA(At, 0, 1); PG8_STAGE(PG8_SB(0, 0), b2, voffB); PG8_STAGE(PG8_SB(0, 1), b2 + hstep, voffB); PG8_STAGE(PG8_SA(0, 0), a2, voffA);
            PG8_WAIT_V(8); PG8_WAIT_L(0); PG8_BAR; PG8_MMA(1, 0, At, B0); PG8_MMA(1, 1, At, B1); PG8_BAR; PG8_SCHED;
            PG8_LDB(B0, 1, 0); PG8_LDB(B1, 1, 1); PG8_SCHED; PG8_LDA(At, 1, 0); PG8_STAGE(PG8_SA(0, 1), a2 + hstep, voffA);
            PG8_WAIT_V(8); PG8_WAIT_L(0); PG8_BAR; PG8_MMA(0, 0, At, B0); PG8_MMA(0, 1, At, B1); PG8_BAR; PG8_SCHED;
            PG8_LDA(At, 1, 1); PG8_STAGE(PG8_SB(1, 0), b3, voffB); PG8_STAGE(PG8_SB(1, 1), b3 + hstep, voffB); PG8_STAGE(PG8_SA(1, 0), a3, voffA);
            PG8_WAIT_V(8); PG8_WAIT_L(0); PG8_BAR; PG8_MMA(1, 0, At, B0); PG8_MMA(1, 1, At, B1); PG8_BAR; PG8_SCHED;
            } else {
            PG8_LDB(B0, 0, 0); PG8_SCHED; PG8_LDA(At, 0, 0); PG8_STAGE(PG8_SA(1, 1), a1 + hstep, voffA);
            PG8_WAIT_L(8); PG8_BAR; PG8_WAIT_L(0); PG8_MMA(0, 0, At, B0); PG8_BAR; PG8_SCHED;
            PG8_LDB(B1, 0, 1); PG8_STAGE(PG8_SB(0, 0), b2, voffB);
            PG8_BAR; PG8_WAIT_L(0); PG8_MMA(0, 1, At, B1); PG8_BAR;
            PG8_LDA(At, 0, 1); PG8_STAGE(PG8_SA(0, 0), a2, voffA);
            PG8_BAR; PG8_WAIT_L(0); PG8_MMA(1, 0, At, B0); PG8_BAR; PG8_SCHED;
            PG8_STAGE(PG8_SB(0, 1), b2 + hstep, voffB);
            PG8_WAIT_V(6); PG8_BAR; PG8_MMA(1, 1, At, B1); PG8_BAR;
            PG8_LDB(B0, 1, 0); PG8_SCHED; PG8_LDA(At, 1, 0); PG8_STAGE(PG8_SA(0, 1), a2 + hstep, voffA);
            PG8_WAIT_L(8); PG8_BAR; PG8_WAIT_L(0); PG8_MMA(0, 0, At, B0); PG8_BAR; PG8_SCHED;
            PG8_LDB(B1, 1, 1); PG8_STAGE(PG8_SB(1, 0), b3, voffB);
            PG8_BAR; PG8_WAIT_L(0); PG8_MMA(0, 1, At, B1); PG8_BAR;
            PG8_LDA(At, 1, 1); PG8_STAGE(PG8_SA(1, 0), a3, voffA);
            PG8_BAR; PG8_WAIT_L(0); PG8_MMA(1, 0, At, B0); PG8_BAR; PG8_SCHED;
            PG8_STAGE(PG8_SB(1, 1), b3 + hstep, voffB);
            PG8_WAIT_V(6); PG8_BAR; PG8_MMA(1, 1, At, B1); PG8_BAR;
            }
        }
        if constexpr (ALIGN_EPI) { if (wr == 0) PG8_BAR; }
        bool keep = false;
        if constexpr (Epi::DUAL) { if (cur.seg == 0) { E.mid(acc, cur, wr, wc, fr, fq); keep = true; } }
        if (!keep) E(acc, cur, wr, wc, fr, fq);
        if (!has_next) break;
        if (!keep) {
#pragma unroll
        for (int a = 0; a < 2; ++a)
#pragma unroll
            for (int b = 0; b < 2; ++b)
#pragma unroll
                for (int m = 0; m < 4; ++m)
#pragma unroll
                    for (int n = 0; n < 2; ++n) acc[a][b][m][n] = (f32x4){0.f, 0.f, 0.f, 0.f};
        }
        cur = nxt; cA = nA; cB = nB; ++ui;
        if constexpr (ALIGN_EPI) { if (wr == 1) PG8_BAR; }
    }
    PG8_WAIT_V(0);
    if constexpr (!ALIGN_EPI) { if (wr == 0) PG8_BAR; }
    PG8_BAR;
#undef PG8_SA
#undef PG8_SB
#undef PG8_STAGE
#undef PG8_LDA
#undef PG8_LDB
#undef PG8_MMA
#undef PG8_WAIT_V
#undef PG8_WAIT_L
#undef PG8_BAR
#undef PG8_SCHED
}

typedef f32x4 AccT[2][2][4][2];

struct EpiInA {
    static constexpr int PERM = 1; static constexpr bool DUAL = false;
    bf16_t *GQ, *GK, *GR, *DQ, *DK, *G1, *G2; float* LA; const float *b_alpha, *gain_q, *gain_k;
    __device__ __forceinline__ void operator()(const AccT& acc, const Unit& u, int wr, int wc, int fr, int fq) const {
        const int pn = u.pn; const int row0 = u.pm * BM + wr * 64 + fr;
        if (pn == 2) {
#pragma unroll
            for (int bj = 0; bj < 2; ++bj) { const int c = bj * HALF + wc * 32 + 8 * fq;
                const f32x4 b0 = *(const f32x4*)(b_alpha + c), b1 = *(const f32x4*)(b_alpha + c + 4);
#pragma unroll
                for (int ai = 0; ai < 2; ++ai)
#pragma unroll
                    for (int m = 0; m < 4; ++m) { float* p = LA + (size_t)(row0 + ai * HALF + m * 16) * 256 + c;
                        f32x4 v0 = acc[ai][bj][m][0] + b0, v1 = acc[ai][bj][m][1] + b1, o0, o1;
#pragma unroll
                        for (int j = 0; j < 4; ++j) { o0[j] = (fminf(v0[j], 0.f) - __logf(1.f + __expf(-fabsf(v0[j])))) * 0.0625f; o1[j] = (fminf(v1[j], 0.f) - __logf(1.f + __expf(-fabsf(v1[j])))) * 0.0625f; }
                        *(f32x4*)p = o0; *(f32x4*)(p + 4) = o1; } }
            return;
        }
        if (pn >= 5 && pn < 9) {
            const bool isq = pn < 7; bf16_t* dst = isq ? DQ : DK; const float* gain = isq ? gain_q : gain_k; const int cb = (isq ? pn - 5 : pn - 7) * 256 + 64 * wc;
            const float osc = isq ? 0.125f * LOG2E : 1.0f;
            f32x4 gv[2][2];
#pragma unroll
            for (int bj = 0; bj < 2; ++bj)
#pragma unroll
                for (int n = 0; n < 2; ++n) gv[bj][n] = *(const f32x4*)(gain + 32 * bj + 8 * fq + 4 * n);
#pragma unroll
            for (int ai = 0; ai < 2; ++ai)
#pragma unroll
                for (int m = 0; m < 4; ++m) { float ss = 0.f;
#pragma unroll
                    for (int bj = 0; bj < 2; ++bj)
#pragma unroll
                        for (int n = 0; n < 2; ++n) { const f32x4 x = acc[ai][bj][m][n]; ss += (x[0] * x[0] + x[1] * x[1]) + (x[2] * x[2] + x[3] * x[3]); }
                    ss += __shfl_xor(ss, 16); ss += __shfl_xor(ss, 32);
                    const float rn = __builtin_amdgcn_rsqf(ss * (1.0f / 64.0f) + EPS) * osc;
                    bf16_t* p = dst + (size_t)(row0 + ai * HALF + m * 16) * 512 + cb + 8 * fq;
#pragma unroll
                    for (int bj = 0; bj < 2; ++bj) { const f32x4 v0 = acc[ai][bj][m][0] * rn * gv[bj][0], v1 = acc[ai][bj][m][1] * rn * gv[bj][1];
                        u32x4 w; w.x = pk2(v0[0], v0[1]); w.y = pk2(v0[2], v0[3]); w.z = pk2(v1[0], v1[1]); w.w = pk2(v1[2], v1[3]);
                        *(u32x4*)(p + 32 * bj) = w; } }
            return;
        }
        int mode, ldc, cb; bf16_t* dst;
        float sc = 1.f;
        if (pn == 0) { mode = 0; dst = GQ; ldc = 256; cb = 0; sc = 0.125f; }
        else if (pn == 1) { mode = 0; dst = GK; ldc = 256; cb = 0; }
        else if (pn < 5) { mode = 1; dst = GR; ldc = 512; cb = (pn - 3) * 256; }
        else if (pn < 13) { mode = 2; dst = G1; ldc = 1024; cb = (pn - 9) * 256; }
        else { mode = 2; dst = G2; ldc = 1024; cb = (pn - 13) * 256; }
#pragma unroll
        for (int ai = 0; ai < 2; ++ai)
#pragma unroll
            for (int m = 0; m < 4; ++m) { bf16_t* p = dst + (size_t)(row0 + ai * HALF + m * 16) * ldc + cb + wc * 32 + 8 * fq;
#pragma unroll
                for (int bj = 0; bj < 2; ++bj) { f32x4 v0 = acc[ai][bj][m][0], v1 = acc[ai][bj][m][1];
                    if (mode == 0) { v0 = v0 * sc; v1 = v1 * sc; }
                    else if (mode == 1) {
#pragma unroll
                        for (int j = 0; j < 4; ++j) { v0[j] = siluf_(v0[j]); v1[j] = siluf_(v1[j]); } }
                    else {
#pragma unroll
                        for (int j = 0; j < 4; ++j) { v0[j] = sigmoidf_(v0[j]); v1[j] = sigmoidf_(v1[j]); } }
                    u32x4 w; w.x = pk2(v0[0], v0[1]); w.y = pk2(v0[2], v0[3]); w.z = pk2(v1[0], v1[1]); w.w = pk2(v1[2], v1[3]);
                    if (mode == 2) __builtin_nontemporal_store(w, (u32x4*)(p + bj * HALF));
                    else *(u32x4*)(p + bj * HALF) = w; } }
    }
};

struct EpiInV {
    static constexpr int PERM = 2; static constexpr bool DUAL = false;
    bf16_t* VT;
    __device__ __forceinline__ void operator()(const AccT& acc, const Unit& u, int wr, int wc, int fr, int fq) const {
        const int ch0 = u.pm * BM + wr * 64 + fr; const int tok0 = u.pn * BM + wc * 32 + 8 * fq; const int b = tok0 >> 12, s0 = tok0 & 4095;
#pragma unroll
        for (int ai = 0; ai < 2; ++ai)
#pragma unroll
            for (int m = 0; m < 4; ++m) { bf16_t* p = VT + ((size_t)b * 1024 + ch0 + ai * HALF + m * 16) * SEQ + s0;
#pragma unroll
                for (int bj = 0; bj < 2; ++bj) { const f32x4 v0 = acc[ai][bj][m][0], v1 = acc[ai][bj][m][1];
                    u32x4 w; w.x = pk2(v0[0], v0[1]); w.y = pk2(v0[2], v0[3]); w.z = pk2(v1[0], v1[1]); w.w = pk2(v1[2], v1[3]);
                    *(u32x4*)(p + bj * HALF) = w; } }
    }
};

struct EpiMerge {
    static constexpr int PERM = 1; static constexpr bool DUAL = true;
    const bf16_t *G1, *G2; bf16_t* MIX;
    __device__ __forceinline__ void mid(AccT& acc, const Unit& u, int wr, int wc, int fr, int fq) const {
        const size_t off0 = (size_t)(u.pm * BM + wr * 64 + fr) * 1024 + u.pn * BM + wc * 32 + 8 * fq;
#pragma unroll
        for (int ai = 0; ai < 2; ++ai)
#pragma unroll
            for (int m = 0; m < 4; ++m)
#pragma unroll
                for (int bj = 0; bj < 2; ++bj) { const size_t off = off0 + (size_t)(ai * HALF + m * 16) * 1024 + bj * HALF;
                    const u32x4 a = __builtin_nontemporal_load((const u32x4*)(G1 + off)), b = *(const u32x4*)(G2 + off);
                    f32x4 r0, r1;
                    r0[0] = bf_lo(a.x) * __builtin_amdgcn_rcpf(bf_lo(b.x)); r0[1] = bf_hi(a.x) * __builtin_amdgcn_rcpf(bf_hi(b.x));
                    r0[2] = bf_lo(a.y) * __builtin_amdgcn_rcpf(bf_lo(b.y)); r0[3] = bf_hi(a.y) * __builtin_amdgcn_rcpf(bf_hi(b.y));
                    r1[0] = bf_lo(a.z) * __builtin_amdgcn_rcpf(bf_lo(b.z)); r1[1] = bf_hi(a.z) * __builtin_amdgcn_rcpf(bf_hi(b.z));
                    r1[2] = bf_lo(a.w) * __builtin_amdgcn_rcpf(bf_lo(b.w)); r1[3] = bf_hi(a.w) * __builtin_amdgcn_rcpf(bf_hi(b.w));
                    acc[ai][bj][m][0] = acc[ai][bj][m][0] * r0; acc[ai][bj][m][1] = acc[ai][bj][m][1] * r1; }
    }
    __device__ __forceinline__ void operator()(const AccT& acc, const Unit& u, int wr, int wc, int fr, int fq) const {
        const size_t off0 = (size_t)(u.pm * BM + wr * 64 + fr) * 1024 + u.pn * BM + wc * 32 + 8 * fq;
#pragma unroll
        for (int ai = 0; ai < 2; ++ai)
#pragma unroll
            for (int m = 0; m < 4; ++m)
#pragma unroll
                for (int bj = 0; bj < 2; ++bj) { const size_t off = off0 + (size_t)(ai * HALF + m * 16) * 1024 + bj * HALF;
                    const u32x4 b = __builtin_nontemporal_load((const u32x4*)(G2 + off));
                    const f32x4 v0 = acc[ai][bj][m][0], v1 = acc[ai][bj][m][1];
                    u32x4 w; w.x = pk2(v0[0] * bf_lo(b.x), v0[1] * bf_hi(b.x)); w.y = pk2(v0[2] * bf_lo(b.y), v0[3] * bf_hi(b.y));
                    w.z = pk2(v1[0] * bf_lo(b.z), v1[1] * bf_hi(b.z)); w.w = pk2(v1[2] * bf_lo(b.w), v1[3] * bf_hi(b.w));
                    *(u32x4*)(MIX + off) = w; }
    }
};

template <bool BB, bool OB>
struct EpiResid {
    static constexpr int PERM = 1; static constexpr bool DUAL = false;
    const void* base; void* out; const float* gate;
    __device__ __forceinline__ void operator()(const AccT& acc, const Unit& u, int wr, int wc, int fr, int fq) const {
        const int row0 = u.pm * BM + wr * 64 + fr; const int col0 = u.pn * BM + wc * 32 + 8 * fq; const int b = row0 >> 12;
        f32x4 gt[2][2];
#pragma unroll
        for (int bj = 0; bj < 2; ++bj)
#pragma unroll
            for (int n = 0; n < 2; ++n) gt[bj][n] = *(const f32x4*)(gate + (size_t)b * NMOD + col0 + bj * HALF + n * 4);
#pragma unroll
        for (int ai = 0; ai < 2; ++ai)
#pragma unroll
            for (int m = 0; m < 4; ++m) { const size_t off = (size_t)(row0 + ai * HALF + m * 16) * DM + col0;
#pragma unroll
                for (int bj = 0; bj < 2; ++bj) { f32x4 b0, b1;
                    if constexpr (BB) { const u32x4 w = *(const u32x4*)((const bf16_t*)base + off + bj * HALF);
                        b0 = (f32x4){bf_lo(w.x), bf_hi(w.x), bf_lo(w.y), bf_hi(w.y)}; b1 = (f32x4){bf_lo(w.z), bf_hi(w.z), bf_lo(w.w), bf_hi(w.w)}; }
                    else { b0 = __builtin_nontemporal_load((const f32x4*)((const float*)base + off + bj * HALF)); b1 = __builtin_nontemporal_load((const f32x4*)((const float*)base + off + bj * HALF + 4)); }
                    const f32x4 o0 = b0 + gt[bj][0] * acc[ai][bj][m][0], o1 = b1 + gt[bj][1] * acc[ai][bj][m][1];
                    if constexpr (OB) { u32x4 w; w.x = pk2(o0[0], o0[1]); w.y = pk2(o0[2], o0[3]); w.z = pk2(o1[0], o1[1]); w.w = pk2(o1[2], o1[3]);
                        *(u32x4*)((bf16_t*)out + off + bj * HALF) = w; }
                    else { __builtin_nontemporal_store(o0, (f32x4*)((float*)out + off + bj * HALF)); __builtin_nontemporal_store(o1, (f32x4*)((float*)out + off + bj * HALF + 4)); } } }
    }
};

struct EpiSwiglu {
    static constexpr int PERM = 1; static constexpr bool DUAL = false;
    bf16_t* ACT;
    __device__ __forceinline__ void operator()(const AccT& acc, const Unit& u, int wr, int wc, int fr, int fq) const {
        const int row0 = u.pm * BM + wr * 64 + fr; const int col0 = u.pn * HALF + wc * 32 + 8 * fq;
#pragma unroll
        for (int ai = 0; ai < 2; ++ai)
#pragma unroll
            for (int m = 0; m < 4; ++m) { const f32x4 g0 = acc[ai][0][m][0], g1 = acc[ai][0][m][1], u0 = acc[ai][1][m][0], u1 = acc[ai][1][m][1];
                f32x4 o0, o1;
#pragma unroll
                for (int j = 0; j < 4; ++j) { o0[j] = siluf_(g0[j]) * u0[j]; o1[j] = siluf_(g1[j]) * u1[j]; }
                u32x4 w; w.x = pk2(o0[0], o0[1]); w.y = pk2(o0[2], o0[3]); w.z = pk2(o1[0], o1[1]); w.w = pk2(o1[2], o1[3]);
                *(u32x4*)(ACT + (size_t)(row0 + ai * HALF + m * 16) * FFH + col0) = w; }
    }
};
}

__device__ __forceinline__ void tr_item(const float* __restrict__ W, int ldw, int c0, int k0, bf16_t* __restrict__ WT, int K, int dst0, LAS float* scr, int lane) {
#pragma unroll
    for (int i = 0; i < 32; ++i) { const int kk = 2 * i + (lane >> 5); scr[kk * 33 + (lane & 31)] = __builtin_nontemporal_load(W + (size_t)(k0 + kk) * ldw + c0 + (lane & 31)); }
    asm volatile("s_waitcnt lgkmcnt(0)" ::: "memory");
    const int c = lane & 7;
#pragma unroll
    for (int j = 0; j < 4; ++j) { const int n = (lane >> 3) + 8 * j; const LAS float* s = scr + (8 * c) * 33 + n;
        u32x4 o; o.x = pk2(s[0 * 33], s[1 * 33]); o.y = pk2(s[2 * 33], s[3 * 33]); o.z = pk2(s[4 * 33], s[5 * 33]); o.w = pk2(s[6 * 33], s[7 * 33]);
        *(u32x4*)(WT + (size_t)(dst0 + n) * K + k0 + 8 * c) = o; }
    asm volatile("s_waitcnt lgkmcnt(0)" ::: "memory");
}

struct Args {
    const float* in[22]; float* out; unsigned char* ws; int ph_lo, ph_hi;
};

__device__ __forceinline__ int wa_src(int nb) {
    const int t = nb >> 3, q = nb & 7;
    if (t == 0) return C_GQ + 32 * q;
    if (t == 1) return C_GK + 32 * q;
    if (t == 2) return -1;
    if (t < 5) return C_GR + (t - 3) * 256 + 32 * q;
    if (t < 9) { const int base = (t < 7) ? C_DQ + (t - 5) * 256 : C_DK + (t - 7) * 256; const int bj = q >> 2, wc = q & 3; return base + 64 * wc + 32 * bj; }
    if (t < 13) return C_G1 + (t - 9) * 256 + 32 * q;
    return C_G2 + (t - 13) * 256 + 32 * q;
}

__device__ __forceinline__ void phase0(const Args& a, LAS unsigned char* lds, int G) {
    const int tid = tid_fresh(), lane = tid & 63, wid = __builtin_amdgcn_readfirstlane(tid >> 6);
    unsigned char* ws = a.ws;
    const float* c_in = a.in[1]; const float* w_ada = a.in[2]; const float* b_ada = a.in[3];
    const float* w_in = a.in[5]; const float* w_up = a.in[6];
    float* mod = (float*)(ws + WS_MOD);
    if (blockIdx.x == 0 && tid < 64) {
        const float* lq1 = a.in[11]; const float* lk1 = a.in[12]; const float* lq2 = a.in[13]; const float* lk2 = a.in[14];
        const float s1 = wave_sum(lq1[lane] * lk1[lane]), s2 = wave_sum(lq2[lane] * lk2[lane]);
        if (lane < 16) ((unsigned*)(ws + WS_MISC))[8 + lane] = 0u;
        if (lane == 0) { ((unsigned*)(ws + WS_MISC))[0] = 0u; ((unsigned*)(ws + WS_MISC))[2] = 0u; ((float*)(ws + WS_MISC))[1] = __expf(s1) - __expf(s2) + 0.2f; }
    }
    if ((int)blockIdx.x < NMOD / 64) {
        LAS float* scT = (LAS float*)lds;
        LAS float* red = (LAS float*)(lds + 65536);
        for (int idx = tid; idx < 16 * 1024; idx += 512) { const int b = idx >> 10, k = idx & 1023; scT[k * 16 + b] = siluf_(c_in[idx]); }
        __syncthreads();
        const int n0 = blockIdx.x * 64;
        float acc[16];
#pragma unroll
        for (int b = 0; b < 16; ++b) acc[b] = 0.f;
        const float* wp = w_ada + (size_t)(wid * 128) * NMOD + n0 + lane;
#pragma unroll 8
        for (int k = 0; k < 128; ++k) { const float wv = wp[(size_t)k * NMOD]; const LAS f32x4* s4 = (const LAS f32x4*)(scT + (wid * 128 + k) * 16);
#pragma unroll
            for (int q = 0; q < 4; ++q) { const f32x4 s = s4[q]; acc[4 * q] += s[0] * wv; acc[4 * q + 1] += s[1] * wv; acc[4 * q + 2] += s[2] * wv; acc[4 * q + 3] += s[3] * wv; } }
#pragma unroll
        for (int b = 0; b < 16; ++b) red[(wid * 16 + b) * 64 + lane] = acc[b];
        __syncthreads();
        for (int o = tid; o < 1024; o += 512) { const int b = o >> 6, l = o & 63; float s = b_ada[n0 + l];
#pragma unroll
            for (int w = 0; w < 8; ++w) s += red[(w * 16 + b) * 64 + l];
            mod[(size_t)b * NMOD + n0 + l] = s; }
        __syncthreads();
    }
    LAS float* scr = (LAS float*)(lds + wid * 16384);
    const int NADA = (G > NMOD / 64) ? NMOD / 64 : G;
    const bool isada = (int)blockIdx.x < NADA;
    const int nslot = isada ? 1 : 2;
    const int slot0 = isada ? 2 * (G - NADA) * 8 + (int)blockIdx.x * 8 + wid : 2 * (((int)blockIdx.x - NADA) * 8 + wid);
    const int NSLOT = 2 * (G - NADA) * 8 + NADA * 8;
    bf16_t* WA = (bf16_t*)(ws + WS_WA); bf16_t* WV = (bf16_t*)(ws + WS_WV); bf16_t* WBG = (bf16_t*)(ws + WS_WBG); bf16_t* WBD = (bf16_t*)(ws + WS_WBD);
    bf16_t* WO = (bf16_t*)(ws + WS_WO); bf16_t* WF1 = (bf16_t*)(ws + WS_WF1); bf16_t* WF2 = (bf16_t*)(ws + WS_WF2);
    constexpr int I_A = 136 * 16, I_V = 32 * 16, I_BG = 32 * 8, I_BD = 32 * 8, I_O = 32 * 16, I_F1 = 176 * 16, I_F2 = 32 * 44;
    constexpr int NITEMS = I_A + I_V + I_BG + I_BD + I_O + I_F1 + I_F2;
    for (int itb = 0; itb < NITEMS; itb += NSLOT) for (int sl = 0; sl < nslot; ++sl) {
        const int it = itb + slot0 + sl; if (it >= NITEMS) continue;
        int r = it;
        if (r < I_A) { const int nb = r >> 4, kb = r & 15; const int src = wa_src(nb); if (src >= 0) tr_item(w_in, INCOLS, src, 64 * kb, WA, 1024, 32 * nb, scr, lane); continue; } r -= I_A;
        if (r < I_V) { const int nb = r >> 4, kb = r & 15; const int src = (nb < 16) ? C_GV + 32 * nb : C_DV + 32 * (nb - 16); tr_item(w_in, INCOLS, src, 64 * kb, WV, 1024, 32 * nb, scr, lane); continue; } r -= I_V;
        if (r < I_BG) { const int nb = r >> 3, kb = r & 7; tr_item(a.in[16], 1024, 32 * nb, 64 * kb, WBG, 512, 32 * nb, scr, lane); continue; } r -= I_BG;
        if (r < I_BD) { const int nb = r >> 3, kb = r & 7; tr_item(a.in[17], 1024, 32 * nb, 64 * kb, WBD, 512, 32 * nb, scr, lane); continue; } r -= I_BD;
        if (r < I_O) { const int nb = r >> 4, kb = r & 15; tr_item(a.in[18], 1024, 32 * nb, 64 * kb, WO, 1024, 32 * nb, scr, lane); continue; } r -= I_O;
        if (r < I_F1) { const int nb = r >> 4, kb = r & 15; const int t = nb >> 3, q = nb & 7; const int src = (q >> 2) * FFH + 128 * t + 32 * (q & 3);
            tr_item(a.in[20], 2 * FFH, src, 64 * kb, WF1, 1024, 32 * nb, scr, lane); continue; } r -= I_F1;
        { const int nb = r / 44, kb = r % 44; tr_item(a.in[21], 1024, 32 * nb, 64 * kb, WF2, FFH, 32 * nb, scr, lane); }
    }
    for (int i = blockIdx.x * 512 + tid; i < 256 * 128; i += G * 512) {
        const int j = i & 255, k0 = (i >> 8) * 8;
        float up[16];
#pragma unroll
        for (int r = 0; r < 16; ++r) up[r] = w_up[r * 256 + j];
        float o[8];
#pragma unroll
        for (int e = 0; e < 8; ++e) { const float* wr_ = w_in + (size_t)(k0 + e) * INCOLS + C_GA; float s = 0.f;
#pragma unroll
            for (int r = 0; r < 16; ++r) s += wr_[r] * up[r];
            o[e] = s; }
        u32x4 w; w.x = pk2(o[0], o[1]); w.y = pk2(o[2], o[3]); w.z = pk2(o[4], o[5]); w.w = pk2(o[6], o[7]);
        *(u32x4*)(WA + (size_t)(512 + j) * 1024 + k0) = w;
    }
}

__device__ __forceinline__ void norm_rows(const float* __restrict__ X, const float* __restrict__ g, const float* __restrict__ mod, int sh_off, int sc_off, bf16_t* __restrict__ H, int G) {
    const int tid = tid_fresh(), lane = tid & 63, wid = tid >> 6;
    const int gw = blockIdx.x * 8 + wid, NGW = G * 8;
    for (int row0 = gw; row0 < MTOK; row0 += 2 * NGW) {
        f32x4 v[2][4]; float ss[2] = {0.f, 0.f};
#pragma unroll
        for (int q = 0; q < 2; ++q) { const int rq = (row0 + q * NGW < MTOK) ? row0 + q * NGW : row0; const f32x4* xr = (const f32x4*)(X + (size_t)rq * DM) + lane;
#pragma unroll
            for (int j = 0; j < 4; ++j) v[q][j] = __builtin_nontemporal_load(xr + 64 * j); }
#pragma unroll
        for (int q = 0; q < 2; ++q)
#pragma unroll
            for (int j = 0; j < 4; ++j) ss[q] += (v[q][j][0] * v[q][j][0] + v[q][j][1] * v[q][j][1]) + (v[q][j][2] * v[q][j][2] + v[q][j][3] * v[q][j][3]);
#pragma unroll
        for (int q = 0; q < 2; ++q) { const int row = (row0 + q * NGW < MTOK) ? row0 + q * NGW : row0; const int b = row >> 12;
            const float rn = __builtin_amdgcn_rsqf(wave_sum(ss[q]) * (1.0f / DM) + EPS);
            const float* mb = mod + (size_t)b * NMOD;
            u32x2* o8 = (u32x2*)(H + (size_t)row * DM) + lane;
#pragma unroll
            for (int j = 0; j < 4; ++j) { const int c = 4 * (lane + 64 * j);
                const f32x4 gv = *(const f32x4*)(g + c), sc = *(const f32x4*)(mb + sc_off + c), sh = *(const f32x4*)(mb + sh_off + c);
                const f32x4 y = v[q][j] * rn * gv * (sc + 1.0f) + sh;
                u32x2 w; w.x = pk2(y[0], y[1]); w.y = pk2(y[2], y[3]); o8[64 * j] = w; } }
    }
}

__device__ __forceinline__ void norm_rows_bf(const bf16_t* __restrict__ X, const float* __restrict__ g, const float* __restrict__ mod, int sh_off, int sc_off, bf16_t* __restrict__ H, int G) {
    const int tid = tid_fresh(), lane = tid & 63, wid = tid >> 6;
    const int gw = blockIdx.x * 8 + wid, NGW = G * 8;
    for (int row0 = gw; row0 < MTOK; row0 += 2 * NGW) {
        u32x4 w[2][2]; float ss[2] = {0.f, 0.f};
#pragma unroll
        for (int q = 0; q < 2; ++q) { const int rq = (row0 + q * NGW < MTOK) ? row0 + q * NGW : row0; const u32x4* xr = (const u32x4*)(X + (size_t)rq * DM + 16 * lane);
            w[q][0] = xr[0]; w[q][1] = xr[1]; }
#pragma unroll
        for (int q = 0; q < 2; ++q) { const int row = (row0 + q * NGW < MTOK) ? row0 + q * NGW : row0; const int b = row >> 12;
            float v[16];
#pragma unroll
            for (int e = 0; e < 2; ++e) { v[8 * e] = bf_lo(w[q][e].x); v[8 * e + 1] = bf_hi(w[q][e].x); v[8 * e + 2] = bf_lo(w[q][e].y); v[8 * e + 3] = bf_hi(w[q][e].y);
                v[8 * e + 4] = bf_lo(w[q][e].z); v[8 * e + 5] = bf_hi(w[q][e].z); v[8 * e + 6] = bf_lo(w[q][e].w); v[8 * e + 7] = bf_hi(w[q][e].w); }
#pragma unroll
            for (int i = 0; i < 16; ++i) ss[q] += v[i] * v[i];
            const float rn = __builtin_amdgcn_rsqf(wave_sum(ss[q]) * (1.0f / DM) + EPS);
            const float* mb = mod + (size_t)b * NMOD; const int c = 16 * lane;
            unsigned o[8];
#pragma unroll
            for (int j = 0; j < 4; ++j) { const f32x4 gv = *(const f32x4*)(g + c + 4 * j), sc = *(const f32x4*)(mb + sc_off + c + 4 * j), sh = *(const f32x4*)(mb + sh_off + c + 4 * j);
                const f32x4 x = (f32x4){v[4 * j], v[4 * j + 1], v[4 * j + 2], v[4 * j + 3]};
                const f32x4 y = x * rn * gv * (sc + 1.0f) + sh; o[2 * j] = pk2(y[0], y[1]); o[2 * j + 1] = pk2(y[2], y[3]); }
            u32x4* op = (u32x4*)(H + (size_t)row * DM + c);
            op[0] = (u32x4){o[0], o[1], o[2], o[3]}; op[1] = (u32x4){o[4], o[5], o[6], o[7]}; }
    }
}

__device__ __forceinline__ void attn_unit(LAS unsigned char* lds, const bf16_t* __restrict__ DQ, const bf16_t* __restrict__ DK, const bf16_t* __restrict__ VT,
                                          bf16_t* __restrict__ OD, const float* __restrict__ g_out, float lam, int b, int h, int qb) {
    const int tid = tid_fresh(), lane = tid & 63, r = lane & 31, hh = lane >> 5;
    const int wid = __builtin_amdgcn_readfirstlane(tid >> 6), sub = wid & 3, map = wid >> 2;
    constexpr int STB = 32768, ST_V = 16384;
    const size_t tok0 = (size_t)b * SEQ;
    bf16x8 qf[4];
    { const bf16_t* qp = DQ + (tok0 + qb * 128 + sub * 32 + r) * 512 + h * 128 + map * 64 + hh * 8;
#pragma unroll
      for (int s = 0; s < 4; ++s) qf[s] = *(const bf16x8*)(qp + 16 * s); }
    asm volatile("" : "+v"(qf[0]), "+v"(qf[1]), "+v"(qf[2]), "+v"(qf[3]));
    const char* ksrc[2]; const char* vsrc[2];
#pragma unroll
    for (int i = 0; i < 2; ++i) { const int key = (4 * i + (lane >> 4)) & 7, c = (lane & 7) ^ key;
        const int krow = ((wid & 3) * 2 + i) * 8 + (lane >> 3), vrow = (wid * 2 + i) * 8 + (lane >> 3);
        ksrc[i] = (const char*)(DK + (tok0 + krow) * 512 + h * 128 + map * 64 + c * 8);
        vsrc[i] = (const char*)(VT + ((size_t)b * 1024 + 512 + h * 128 + vrow) * SEQ + c * 8); }
    const unsigned dbase = (unsigned)wid * 2048u;
#define AT_DMA(t, st) do { _Pragma("unroll") for (int i_ = 0; i_ < 2; ++i_) { \
        __builtin_amdgcn_global_load_lds((const unsigned*)(ksrc[i_] + (size_t)(t) * 65536), (LAS unsigned*)(lds + (st) * STB + dbase + i_ * 1024), 16, 0, 0); \
        __builtin_amdgcn_global_load_lds((const unsigned*)(vsrc[i_] + (size_t)(t) * 128), (LAS unsigned*)(lds + (st) * STB + ST_V + dbase + i_ * 1024), 16, 0, 0); } } while (0)
    const int NT = 2 * qb + 2, my_nt = (sub < 2) ? NT - 1 : NT;
    f32x16 o[4];
#pragma unroll
    for (int d = 0; d < 4; ++d)
#pragma unroll
        for (int i = 0; i < 16; ++i) o[d][i] = 0.f;
    float lsum = 0.f;
    int foff[4];
#pragma unroll
    for (int s = 0; s < 4; ++s) foff[s] = r * 128 + (((2 * s + hh) ^ ((r >> 1) & 7)) * 16);
    AT_DMA(0, 0); AT_DMA(1, 1);
    asm volatile("s_waitcnt vmcnt(0)" ::: "memory"); __builtin_amdgcn_s_barrier(); asm volatile("" ::: "memory");
    const int NP = qb + 1;
    float ls = 0.f;
#define AT_SB() __builtin_amdgcn_sched_barrier(0)
#define AT_KLD(KB) do { _Pragma("unroll") for (int s_ = 0; s_ < 4; ++s_) { kf[2 * s_] = *(const LAS bf16x8*)((KB) + foff[s_]); kf[2 * s_ + 1] = *(const LAS bf16x8*)((KB) + 4096 + foff[s_]); } } while (0)
#define AT_QK(S0, S1) do { _Pragma("unroll") for (int i_ = 0; i_ < 16; ++i_) { S0[i_] = 0.f; S1[i_] = 0.f; } \
        _Pragma("unroll") for (int s_ = 0; s_ < 4; ++s_) { S0 = __builtin_amdgcn_mfma_f32_32x32x16_bf16(kf[2 * s_], qf[s_], S0, 0, 0, 0); \
            S1 = __builtin_amdgcn_mfma_f32_32x32x16_bf16(kf[2 * s_ + 1], qf[s_], S1, 0, 0, 0); } } while (0)
#define AT_EXPBLK(SV, Q, OUT) do { _Pragma("unroll") for (int i_ = 0; i_ < 8; ++i_) { SV[(Q) + i_] = __builtin_amdgcn_exp2f(SV[(Q) + i_]); } \
        ls += ((SV[(Q)] + SV[(Q) + 1]) + (SV[(Q) + 2] + SV[(Q) + 3])) + ((SV[(Q) + 4] + SV[(Q) + 5]) + (SV[(Q) + 6] + SV[(Q) + 7])); \
        u32x4 w_; w_.x = pk2(SV[(Q)], SV[(Q) + 1]); w_.y = pk2(SV[(Q) + 2], SV[(Q) + 3]); w_.z = pk2(SV[(Q) + 4], SV[(Q) + 5]); w_.w = pk2(SV[(Q) + 6], SV[(Q) + 7]); \
        OUT = __builtin_bit_cast(bf16x8, w_); } while (0)
#define AT_PV(VF, PF) do { _Pragma("unroll") for (int dt_ = 0; dt_ < 4; ++dt_) o[dt_] = __builtin_amdgcn_mfma_f32_32x32x16_bf16(VF[dt_], PF, o[dt_], 0, 0, 0); } while (0)
#define AT_VLD(VF, VB, KS) do { _Pragma("unroll") for (int dt_ = 0; dt_ < 4; ++dt_) VF[dt_] = *(const LAS bf16x8*)((VB) + dt_ * 4096 + foff[KS]); } while (0)
#define AT_TILE(STG) do { const LAS unsigned char* kb_ = lds + (STG) * STB + map * 8192; const LAS unsigned char* vb_ = lds + (STG) * STB + ST_V; \
        f32x16 a0, a1; AT_KLD(kb_); AT_VLD(vfa, vb_, 0); AT_PV(vfb, pfn); AT_SB(); AT_QK(a0, a1); AT_SB(); AT_EXPBLK(a0, 0, pfc); AT_SB(); \
        AT_VLD(vfb, vb_, 1); AT_PV(vfa, pfc); AT_EXPBLK(a0, 8, pfn); AT_SB(); \
        AT_VLD(vfa, vb_, 2); AT_PV(vfb, pfn); AT_EXPBLK(a1, 0, pfc); AT_SB(); \
        AT_VLD(vfb, vb_, 3); AT_PV(vfa, pfc); AT_EXPBLK(a1, 8, pfn); AT_SB(); } while (0)
    bf16x8 kf[8], vfa[4], vfb[4], pfc, pfn;
#pragma unroll
    for (int i = 0; i < 8; ++i) { pfn[i] = 0;
#pragma unroll
        for (int dt = 0; dt < 4; ++dt) vfb[dt][i] = 0; }
    for (int j = 0; j < NP - 1; ++j) {
        const int st0 = (j & 1) * 2, sn = ((j + 1) & 1) * 2;
        const LAS unsigned char* kb0 = lds + st0 * STB + map * 8192; const LAS unsigned char* vb0 = lds + st0 * STB + ST_V;
        const LAS unsigned char* kb1 = kb0 + STB; const LAS unsigned char* vb1 = vb0 + STB;
        f32x16 a0, a1, b0, b1;
        AT_DMA(2 * j + 2, sn); AT_KLD(kb0); AT_VLD(vfa, vb0, 0); AT_PV(vfb, pfn); AT_SB();
        AT_QK(a0, a1); AT_SB();
        AT_DMA(2 * j + 3, sn + 1); AT_KLD(kb1); AT_SB();
        AT_QK(b0, b1); AT_EXPBLK(a0, 0, pfc); AT_SB();
        AT_VLD(vfb, vb0, 1); AT_PV(vfa, pfc); AT_EXPBLK(a0, 8, pfn); AT_SB();
        AT_VLD(vfa, vb0, 2); AT_PV(vfb, pfn); AT_EXPBLK(a1, 0, pfc); AT_SB();
        AT_VLD(vfb, vb0, 3); AT_PV(vfa, pfc); AT_EXPBLK(a1, 8, pfn); AT_SB();
        AT_VLD(vfa, vb1, 0); AT_PV(vfb, pfn); AT_EXPBLK(b0, 0, pfc); AT_SB();
        AT_VLD(vfb, vb1, 1); AT_PV(vfa, pfc); AT_EXPBLK(b0, 8, pfn); AT_SB();
        AT_VLD(vfa, vb1, 2); AT_PV(vfb, pfn); AT_EXPBLK(b1, 0, pfc); AT_SB();
        AT_VLD(vfb, vb1, 3); AT_PV(vfa, pfc); AT_EXPBLK(b1, 8, pfn); AT_SB();
        asm volatile("s_waitcnt vmcnt(0)" ::: "memory");
        __builtin_amdgcn_s_barrier(); asm volatile("" ::: "memory");
    }
    {
        const int st0 = ((NP - 1) & 1) * 2;
        AT_TILE(st0);
        if (sub >= 2) AT_TILE(st0 + 1);
        AT_PV(vfb, pfn);
        __builtin_amdgcn_s_barrier(); asm volatile("" ::: "memory");
    }
    lsum += ls;
#undef AT_SB
#undef AT_KLD
#undef AT_QK
#undef AT_EXPBLK
#undef AT_PV
#undef AT_VLD
#undef AT_TILE
#undef AT_DMA
    lsum += __shfl_xor(lsum, 32);
    const float rl = 1.0f / lsum;
    LAS float* xch = (LAS float*)lds;
    if (map == 1) {
#pragma unroll
        for (int dt = 0; dt < 4; ++dt)
#pragma unroll
            for (int i = 0; i < 16; ++i) xch[((sub * 4 + dt) * 16 + i) * 64 + lane] = o[dt][i] * rl;
    }
    __syncthreads();
    if (map == 0) {
        float ss = 0.f;
#pragma unroll
        for (int dt = 0; dt < 4; ++dt)
#pragma unroll
            for (int i = 0; i < 16; ++i) { const float v = o[dt][i] * rl - lam * xch[((sub * 4 + dt) * 16 + i) * 64 + lane]; o[dt][i] = v; ss += v * v; }
        ss += __shfl_xor(ss, 32);
        const float rn = __builtin_amdgcn_rsqf(ss * (1.0f / 128.0f) + EPS) * 0.8f;
        LAS unsigned char* stg = lds + 65536 + sub * (32 * 272);
#pragma unroll
        for (int dt = 0; dt < 4; ++dt)
#pragma unroll
            for (int g4 = 0; g4 < 4; ++g4) { const int dv0 = 32 * dt + 8 * g4 + 4 * hh; const f32x4 gv = *(const f32x4*)(g_out + dv0);
                u32x2 w; w.x = pk2(o[dt][4 * g4] * rn * gv[0], o[dt][4 * g4 + 1] * rn * gv[1]); w.y = pk2(o[dt][4 * g4 + 2] * rn * gv[2], o[dt][4 * g4 + 3] * rn * gv[3]);
                *(LAS u32x2*)(stg + r * 272 + dv0 * 2) = w; }
        asm volatile("s_waitcnt lgkmcnt(0)" ::: "memory");
        bf16_t* op = OD + (tok0 + qb * 128 + sub * 32) * 512 + h * 128;
#pragma unroll
        for (int i = 0; i < 8; ++i) { const int row = i * 4 + (lane >> 4), ch = lane & 15;
            const u32x4 v = *(const LAS u32x4*)(stg + row * 272 + ch * 16);
            *(u32x4*)(op + (size_t)row * 512 + ch * 8) = v; }
    }
    __syncthreads();
}

__device__ __forceinline__ void gla_item(LAS unsigned char* lds, const bf16_t* __restrict__ GQ, const bf16_t* __restrict__ GK, const float* __restrict__ LA,
                                         const bf16_t* __restrict__ VT, const bf16_t* __restrict__ GR, const float* __restrict__ g_out, bf16_t* __restrict__ OG, int b, int h) {
    constexpr int KP = 144;
    constexpr int O_QF = 0, O_QB = 9216, O_KF = 18432, O_KB = 27648, O_KDT = 36864, O_VT = 46080, O_ST = 64512, O_AL = 82944, O_SEG = 92160, O_DEC = 100352, O_SSQ = 100608, O_GR = 102400, O_OS = 119808, GP = 272;
    const int tid = tid_fresh(), lane = tid & 63, r = lane & 31, hh = lane >> 5;
    const int wid = __builtin_amdgcn_readfirstlane(tid >> 6);
    const int dp = tid & 31, sg = tid >> 5;
    const int dkt = wid >> 2, dvt = wid & 3, lt = wid >> 2;
    LAS f32x2* segtot = (LAS f32x2*)(lds + O_SEG); LAS float* dec = (LAS float*)(lds + O_DEC); LAS float* ssq = (LAS float*)(lds + O_SSQ);
    f32x16 S;
#pragma unroll
    for (int i = 0; i < 16; ++i) S[i] = 0.f;
    const size_t rbase = (size_t)b * SEQ * 256 + (size_t)(4 * sg) * 256 + h * 64 + 2 * dp;
    const bf16_t* vbase0 = VT + ((size_t)b * 1024 + h * 128 + (tid >> 3)) * SEQ + (tid & 7) * 8;
    f32x2 cum[4], la_n[4]; unsigned q_n[4], k_n[4]; u32x4 v_n[2], g_n[2];
    const int goff = (tid >> 4) * 512 + (tid & 15) * 8;
    const bf16_t* gbase0 = GR + (size_t)b * SEQ * 512 + h * 128;
    bf16_t* obase0 = OG + (size_t)b * SEQ * 512 + h * 128;
#pragma unroll
    for (int i = 0; i < 4; ++i) { cum[i] = *(const f32x2*)(LA + rbase + i * 256); la_n[i] = *(const f32x2*)(LA + rbase + 64 * 256 + i * 256);
        q_n[i] = *(const unsigned*)(GQ + rbase + i * 256); k_n[i] = *(const unsigned*)(GK + rbase + i * 256); }
#pragma unroll
    for (int j = 0; j < 2; ++j) { v_n[j] = *(const u32x4*)(vbase0 + (size_t)j * 64 * SEQ); g_n[j] = *(const u32x4*)(gbase0 + goff + j * 32 * 512); }
#pragma unroll
    for (int i = 1; i < 4; ++i) cum[i] += cum[i - 1];
    segtot[sg * 32 + dp] = cum[3];
    __syncthreads();
    for (int n = 0; n < SEQ / 64; ++n) {
        const size_t t0 = (size_t)b * SEQ + 64 * n;
        LAS f32x2* segc = segtot + (n & 1) * 512; LAS f32x2* segn = segtot + ((n + 1) & 1) * 512;
        {
            f32x2 prefix = {0.f, 0.f}, total = {0.f, 0.f};
#pragma unroll 4
            for (int s = 0; s < 16; ++s) { const f32x2 v = segc[s * 32 + dp]; total += v; if (s < sg) prefix += v; }
            f32x2 etot; etot.x = __expf(total.x); etot.y = __expf(total.y);
            float kd0[4], kd1[4];
#pragma unroll
            for (int i = 0; i < 4; ++i) { const f32x2 cm = prefix + cum[i]; f32x2 ep, em; ep.x = __expf(cm.x); ep.y = __expf(cm.y);
                em.x = __builtin_amdgcn_rcpf(ep.x); em.y = __builtin_amdgcn_rcpf(ep.y);
                const float q0 = bf_lo(q_n[i]), q1 = bf_hi(q_n[i]), k0 = bf_lo(k_n[i]), k1 = bf_hi(k_n[i]);
                const int o = (4 * sg + i) * KP + dp * 4;
                *(LAS unsigned*)(lds + O_QF + o) = pk2(q0 * ep.x, q1 * ep.y);
                *(LAS unsigned*)(lds + O_QB + o) = pk2(q0 * em.x, q1 * em.y);
                *(LAS unsigned*)(lds + O_KF + o) = pk2(k0 * em.x, k1 * em.y);
                *(LAS unsigned*)(lds + O_KB + o) = pk2(k0 * ep.x, k1 * ep.y);
                kd0[i] = k0 * (etot.x * em.x); kd1[i] = k1 * (etot.y * em.y); }
            u32x2 w0, w1; w0.x = pk2(kd0[0], kd0[1]); w0.y = pk2(kd0[2], kd0[3]); w1.x = pk2(kd1[0], kd1[1]); w1.y = pk2(kd1[2], kd1[3]);
            *(LAS u32x2*)(lds + O_KDT + (2 * dp) * KP + sg * 8) = w0;
            *(LAS u32x2*)(lds + O_KDT + (2 * dp + 1) * KP + sg * 8) = w1;
            if (sg == 0) { dec[2 * dp] = etot.x; dec[2 * dp + 1] = etot.y; }
#pragma unroll
            for (int j = 0; j < 2; ++j) { const int c = tid + 512 * j; const int ch = c & 7; LAS unsigned char* vp = lds + O_VT + (c >> 3) * KP + ((ch >> 1) * 16 + (ch & 1) * 4) * 2;
                u32x2 lo, hi; lo.x = v_n[j].x; lo.y = v_n[j].y; hi.x = v_n[j].z; hi.y = v_n[j].w; *(LAS u32x2*)vp = lo; *(LAS u32x2*)(vp + 16) = hi; }
            { const int n1 = (n + 1 < SEQ / 64) ? n + 1 : n;
#pragma unroll
              for (int i = 0; i < 4; ++i) { const size_t o1 = rbase + (size_t)n1 * 64 * 256 + i * 256; q_n[i] = *(const unsigned*)(GQ + o1); k_n[i] = *(const unsigned*)(GK + o1); }
#pragma unroll
              for (int j = 0; j < 2; ++j) v_n[j] = *(const u32x4*)(vbase0 + (size_t)j * 64 * SEQ + 64 * n1); }
        }
        __syncthreads();
        if (wid < 4) {
            const int ltile = (wid == 1 || wid == 2) ? 1 : 0, mtile = (wid == 1 || wid == 3) ? 1 : 0;
            const bool needf = (wid != 3), needb = (wid != 2);
            f32x16 af, ab;
#pragma unroll
            for (int i = 0; i < 16; ++i) { af[i] = 0.f; ab[i] = 0.f; }
            const int ko = (32 * mtile + r) * KP + hh * 16, qo = (32 * ltile + r) * KP + hh * 16;
            if (needf) {
#pragma unroll
                for (int s = 0; s < 4; ++s) af = __builtin_amdgcn_mfma_f32_32x32x16_bf16(*(const LAS bf16x8*)(lds + O_KF + ko + s * 32), *(const LAS bf16x8*)(lds + O_QF + qo + s * 32), af, 0, 0, 0);
            }
            if (needb) {
#pragma unroll
                for (int s = 0; s < 4; ++s) ab = __builtin_amdgcn_mfma_f32_32x32x16_bf16(*(const LAS bf16x8*)(lds + O_KB + ko + s * 32), *(const LAS bf16x8*)(lds + O_QB + qo + s * 32), ab, 0, 0, 0);
            }
            const int lg = 32 * ltile + r;
#pragma unroll
            for (int g4 = 0; g4 < 4; ++g4) { float v[4];
#pragma unroll
                for (int j = 0; j < 4; ++j) { const int mg = 32 * mtile + 8 * g4 + 4 * hh + j; v[j] = (lg >= mg) ? af[4 * g4 + j] : ab[4 * g4 + j]; }
                u32x2 w; w.x = pk2(v[0], v[1]); w.y = pk2(v[2], v[3]);
                *(LAS u32x2*)(lds + O_AL + lg * KP + (32 * mtile + 8 * g4 + 4 * hh) * 2) = w; }
        }
#pragma unroll
        for (int g4 = 0; g4 < 4; ++g4) { u32x2 w; w.x = pk2(S[4 * g4], S[4 * g4 + 1]); w.y = pk2(S[4 * g4 + 2], S[4 * g4 + 3]);
            *(LAS u32x2*)(lds + O_ST + (32 * dvt + r) * KP + (32 * dkt + 8 * g4 + 4 * hh) * 2) = w; }
#pragma unroll
        for (int j = 0; j < 2; ++j) { const int c = tid + 512 * j; *(LAS u32x4*)(lds + O_GR + (c >> 4) * GP + (c & 15) * 16) = g_n[j]; }
        { const int n1 = (n + 1 < SEQ / 64) ? n + 1 : n;
#pragma unroll
          for (int j = 0; j < 2; ++j) g_n[j] = *(const u32x4*)(gbase0 + (size_t)n1 * 64 * 512 + goff + j * 32 * 512); }
        if (n > 0) {
#pragma unroll
            for (int j = 0; j < 2; ++j) { const int c = tid + 512 * j; const u32x4 v = *(const LAS u32x4*)(lds + O_OS + (c >> 4) * GP + (c & 15) * 16);
                *(u32x4*)(obase0 + (size_t)(n - 1) * 64 * 512 + goff + j * 32 * 512) = v; }
        }
#pragma unroll
        for (int i = 0; i < 4; ++i) cum[i] = la_n[i];
#pragma unroll
        for (int i = 1; i < 4; ++i) cum[i] += cum[i - 1];
        segn[sg * 32 + dp] = cum[3];
        { const int n2 = (n + 2 < SEQ / 64) ? n + 2 : SEQ / 64 - 1;
#pragma unroll
          for (int i = 0; i < 4; ++i) la_n[i] = *(const f32x2*)(LA + rbase + (size_t)n2 * 64 * 256 + i * 256); }
        __syncthreads();
        f32x16 o;
#pragma unroll
        for (int i = 0; i < 16; ++i) o[i] = 0.f;
        {
            const int vo = (32 * dvt + r) * KP + hh * 16, lo = (32 * lt + r) * KP + hh * 16;
#pragma unroll
            for (int s = 0; s < 4; ++s) o = __builtin_amdgcn_mfma_f32_32x32x16_bf16(*(const LAS bf16x8*)(lds + O_VT + vo + s * 32), *(const LAS bf16x8*)(lds + O_AL + lo + s * 32), o, 0, 0, 0);
#pragma unroll
            for (int s = 0; s < 4; ++s) o = __builtin_amdgcn_mfma_f32_32x32x16_bf16(*(const LAS bf16x8*)(lds + O_ST + vo + s * 32), *(const LAS bf16x8*)(lds + O_QF + lo + s * 32), o, 0, 0, 0);
#pragma unroll
            for (int g4 = 0; g4 < 4; ++g4) { const f32x4 dc = *(const LAS f32x4*)(dec + 32 * dkt + 8 * g4 + 4 * hh);
#pragma unroll
                for (int j = 0; j < 4; ++j) S[4 * g4 + j] *= dc[j]; }
            const int ka = (32 * dkt + r) * KP + hh * 16;
#pragma unroll
            for (int s = 0; s < 4; ++s) S = __builtin_amdgcn_mfma_f32_32x32x16_bf16(*(const LAS bf16x8*)(lds + O_KDT + ka + s * 32), *(const LAS bf16x8*)(lds + O_VT + vo + s * 32), S, 0, 0, 0);
        }
        float ss = 0.f;
#pragma unroll
        for (int i = 0; i < 16; ++i) ss += o[i] * o[i];
        ss += __shfl_xor(ss, 32);
        if (hh == 0) ssq[(lt * 4 + dvt) * 32 + r] = ss;
        __syncthreads();
        {
            const float tot = (ssq[(lt * 4 + 0) * 32 + r] + ssq[(lt * 4 + 1) * 32 + r]) + (ssq[(lt * 4 + 2) * 32 + r] + ssq[(lt * 4 + 3) * 32 + r]);
            const float rn = __builtin_amdgcn_rsqf(tot * (1.0f / 128.0f) + EPS);
#pragma unroll
            for (int g4 = 0; g4 < 4; ++g4) { const int dv0 = 32 * dvt + 8 * g4 + 4 * hh; const int lo_ = (32 * lt + r) * GP + dv0 * 2;
                const u32x2 gt = *(const LAS u32x2*)(lds + O_GR + lo_); const f32x4 gv = *(const f32x4*)(g_out + dv0);
                u32x2 w; w.x = pk2(o[4 * g4] * rn * gv[0] * bf_lo(gt.x), o[4 * g4 + 1] * rn * gv[1] * bf_hi(gt.x));
                w.y = pk2(o[4 * g4 + 2] * rn * gv[2] * bf_lo(gt.y), o[4 * g4 + 3] * rn * gv[3] * bf_hi(gt.y));
                *(LAS u32x2*)(lds + O_OS + lo_) = w; }
        }
    }
    __syncthreads();
#pragma unroll
    for (int j = 0; j < 2; ++j) { const int c = tid + 512 * j; const u32x4 v = *(const LAS u32x4*)(lds + O_OS + (c >> 4) * GP + (c & 15) * 16);
        *(u32x4*)(obase0 + (size_t)(SEQ / 64 - 1) * 64 * 512 + goff + j * 32 * 512) = v; }
    __syncthreads();
}

#define XB_TMO      128
#define XB_XCNT(j)  (256  + 64 * (j))
#define XB_XSUB(j)  (1280 + 64 * (j))
#define XB_XGEN(j)  (2304 + 64 * (j))
#define XB_TOP      3328
#define XB_TOPGEN   3392
#define XCD_BAR_WORDS 3456
#define XB_SPIN_CAP (1u << 18)

__device__ __forceinline__ unsigned xb_ld(unsigned* p)              { return __hip_atomic_load(p, __ATOMIC_RELAXED, __HIP_MEMORY_SCOPE_AGENT); }
__device__ __forceinline__ unsigned xb_add(unsigned* p, unsigned v) { return __hip_atomic_fetch_add(p, v, __ATOMIC_RELAXED, __HIP_MEMORY_SCOPE_AGENT); }
__device__ __forceinline__ unsigned xb_xcc_id() { return (unsigned)__builtin_amdgcn_s_getreg((3 << 11) | 20) & 0xFu; }
#define XB_SPIN(cond, bar) do { unsigned _sp = 0; while (cond) { __builtin_amdgcn_s_sleep(1); \
    if ((++_sp & 255u) == 0u) { if (xb_ld(&(bar)[XB_TMO])) break; if (_sp > XB_SPIN_CAP) { atomicAdd(&(bar)[XB_TMO], 1u); break; } } } } while (0)

struct XcdBarrier {
    unsigned* bar; unsigned x;
    volatile LAS unsigned* st;
};

__device__ __forceinline__ XcdBarrier xcd_barrier_post(unsigned* bar, volatile LAS unsigned* st) {
    XcdBarrier b; b.bar = bar; b.x = xb_xcc_id(); b.st = st;
    if (threadIdx.x == 0) (void)xb_add(&bar[XB_XCNT(b.x)], 1u);
    return b;
}
__device__ __forceinline__ void xcd_barrier_complete(unsigned* bar, unsigned x, unsigned& nloc, unsigned& nx) {
    const unsigned G = gridDim.x * gridDim.y * gridDim.z;
    unsigned sum, cnt, mine, sp = 0u;
    for (;;) {
        sum = 0u; cnt = 0u; mine = 0u;
#pragma unroll
        for (unsigned j = 0; j < 16; ++j) { const unsigned c = xb_ld(&bar[XB_XCNT(j)]); sum += c; cnt += (c > 0u) ? 1u : 0u; mine = (j == x) ? c : mine; }
        if (sum == G) break;
        __builtin_amdgcn_s_sleep(1);
        if ((++sp & 255u) == 0u) { if (xb_ld(&bar[XB_TMO])) break; if (sp > XB_SPIN_CAP) { atomicAdd(&bar[XB_TMO], 1u); break; } }
    }
    nloc = mine > 0u ? mine : 1u; nx = cnt > 0u ? cnt : 1u;
}

__device__ __forceinline__ void xcd_barrier(const XcdBarrier& b) {
    asm volatile("s_waitcnt vmcnt(0)" ::: "memory");
    __syncthreads();
    if (threadIdx.x == 0) {
        unsigned* bar = b.bar;
        __builtin_amdgcn_s_waitcnt(0);
        unsigned nloc = b.st[0], nx = b.st[1];
        if (nloc == 0u) { xcd_barrier_complete(bar, b.x, nloc, nx); b.st[0] = nloc; b.st[1] = nx; }
        const unsigned old = xb_add(&bar[XB_XSUB(b.x)], 1u);
        const unsigned gen = old / nloc;
        if (old + 1u == (gen + 1u) * nloc) {
            __builtin_amdgcn_fence(__ATOMIC_RELEASE, "agent");
            asm volatile("s_waitcnt vmcnt(0)" ::: "memory");
            const unsigned og = xb_add(&bar[XB_TOP], 1u);
            const unsigned tg = og / nx;
            if (og + 1u == (tg + 1u) * nx) xb_add(&bar[XB_TOPGEN], 1u);
            else XB_SPIN(xb_ld(&bar[XB_TOPGEN]) == tg, bar);
            __builtin_amdgcn_fence(__ATOMIC_ACQUIRE, "agent");
            xb_add(&bar[XB_XGEN(b.x)], 1u);
            asm volatile("s_waitcnt vmcnt(0)" ::: "memory");
        } else {
            XB_SPIN(xb_ld(&bar[XB_XGEN(b.x)]) == gen, bar);
            __builtin_amdgcn_fence(__ATOMIC_ACQUIRE, "agent");
            asm volatile("s_waitcnt vmcnt(0)" ::: "memory");
        }
    }
    __syncthreads();
}


constexpr int NPHASE = 9;
#ifndef PROBE_MODE
#define PROBE_MODE 0
#endif
__global__ void __launch_bounds__(512, 2) fwd_kernel(Args args) {
    extern __shared__ __attribute__((aligned(16))) unsigned char lds_raw[];
    LAS unsigned char* lds = (LAS unsigned char*)lds_raw;
    cg::grid_group grid = cg::this_grid();
    const int G = gridDim.x; const int lo = args.ph_lo, hi = args.ph_hi;
    unsigned char* ws = args.ws;
    const float* x = args.in[0];
    float* mod = (float*)(ws + WS_MOD);
    bf16_t* H = (bf16_t*)(ws + WS_H);
#define IN(k) (lo <= (k) && (k) < hi)
    { volatile LAS unsigned* st0 = (volatile LAS unsigned*)(lds + 140016); if (threadIdx.x < 2) st0[threadIdx.x] = 0u; }
    __syncthreads();
    XcdBarrier xbar = xcd_barrier_post((unsigned*)(ws + WS_BAR), (volatile LAS unsigned*)(lds + 140016));
    if (lo < 0) grid.sync();
#define SEAM(k) do { if (IN(k) && IN((k) + 1)) xcd_barrier(xbar); } while (0)
    if (IN(0)) phase0(args, lds, G);
    SEAM(0);
    if (IN(1)) norm_rows(x, args.in[4], mod, 0, DM, H, G);
    SEAM(1);
    if (IN(2)) {
        { pg8::Gemm g{H, H, (const bf16_t*)(ws + WS_WA), (const bf16_t*)(ws + WS_WA), MTOK, NA, DM};
          typedef pg8::StaticOrder<MTOK / 256, NA / 256, 0> SO; SO S; S.init(G, (int)blockIdx.x);
          pg8::EpiInA E{(bf16_t*)(ws + WS_GQ), (bf16_t*)(ws + WS_GK), (bf16_t*)(ws + WS_GR), (bf16_t*)(ws + WS_DQ), (bf16_t*)(ws + WS_DK), (bf16_t*)(ws + WS_G1), (bf16_t*)(ws + WS_G2),
                        (float*)(ws + WS_LA), args.in[7], args.in[9], args.in[10]};
          pg8::gemm_phase<pg8::EpiInA, SO, true, true>(lds, g, S, E); }
        { pg8::Gemm g{(const bf16_t*)(ws + WS_WV), (const bf16_t*)(ws + WS_WV), H, H, 1024, MTOK, DM};
          typedef pg8::StaticOrder<4, MTOK / 256, 0> SO; SO S; S.init(G, (int)blockIdx.x);
          pg8::EpiInV E{(bf16_t*)(ws + WS_VT)};
          pg8::gemm_phase<pg8::EpiInV, SO, true, true>(lds, g, S, E); }
    }
    SEAM(2);
    if (IN(3)) {
        unsigned* qctr = (unsigned*)(ws + WS_MISC) + 8;
        const float lam = ((const float*)(ws + WS_MISC))[1];
        LAS unsigned* slot = (LAS unsigned*)(lds + 140000);
        for (int kq = 0; kq < 8; ++kq) {
            const int xl = ((int)blockIdx.x + kq) & 7;
            for (;;) {
                if (threadIdx.x == 0) *slot = __hip_atomic_fetch_add(qctr + xl, 1u, __ATOMIC_RELAXED, __HIP_MEMORY_SCOPE_AGENT);
                __syncthreads();
                const unsigned item = *slot;
                __syncthreads();
                if (item >= 8u + 256u) break;
                if (item < 8u) { const int bh = xl * 8 + (int)item;
                    gla_item(lds, (const bf16_t*)(ws + WS_GQ), (const bf16_t*)(ws + WS_GK), (const float*)(ws + WS_LA), (const bf16_t*)(ws + WS_VT), (const bf16_t*)(ws + WS_GR),
                             args.in[8], (bf16_t*)(ws + WS_OG), bh >> 2, bh & 3); }
                else { const unsigned a = item - 8u; const int bh = xl * 8 + (int)(a >> 5), qb = 31 - (int)(a & 31);
                    attn_unit(lds, (const bf16_t*)(ws + WS_DQ), (const bf16_t*)(ws + WS_DK), (const bf16_t*)(ws + WS_VT), (bf16_t*)(ws + WS_OD), args.in[15], lam, bh >> 2, bh & 3, qb); }
            }
        }
    }
#if PROBE_MODE == 1
    grid.sync();
    {
        unsigned* qctr = (unsigned*)(ws + WS_MISC) + 2;
        const float lam = ((const float*)(ws + WS_MISC))[1];
        LAS unsigned* slot = (LAS unsigned*)(lds + 140000);
        for (;;) {
            if (threadIdx.x == 0) *slot = __hip_atomic_fetch_add(qctr, 1u, __ATOMIC_RELAXED, __HIP_MEMORY_SCOPE_AGENT);
            __syncthreads();
            const unsigned item = *slot;
            __syncthreads();
            if (item >= 64u + 2048u) break;
            if (item < 64u) gla_item(lds, (const bf16_t*)(ws + WS_GQ), (const bf16_t*)(ws + WS_GK), (const float*)(ws + WS_LA), (const bf16_t*)(ws + WS_VT), (const bf16_t*)(ws + WS_GR),
                                     args.in[8], (bf16_t*)(ws + WS_OG), (int)(item >> 2), (int)(item & 3));
            else { const unsigned a = item - 64u; const int qb = 31 - (int)(a >> 6), bh = (int)(a & 63);
                attn_unit(lds, (const bf16_t*)(ws + WS_DQ), (const bf16_t*)(ws + WS_DK), (const bf16_t*)(ws + WS_VT), (bf16_t*)(ws + WS_OD), args.in[15], lam, bh >> 2, bh & 3, qb); }
        }
    }
#elif PROBE_MODE == 2
    grid.sync();
    if (blockIdx.x < 64) gla_item(lds, (const bf16_t*)(ws + WS_GQ), (const bf16_t*)(ws + WS_GK), (const float*)(ws + WS_LA), (const bf16_t*)(ws + WS_VT), (const bf16_t*)(ws + WS_GR),
                                     args.in[8], (bf16_t*)(ws + WS_OG), (int)(blockIdx.x >> 2), (int)(blockIdx.x & 3));
#endif
    SEAM(3);
    if (IN(4)) {
        pg8::Gemm g{(const bf16_t*)(ws + WS_OG), (const bf16_t*)(ws + WS_OD), (const bf16_t*)(ws + WS_WBG), (const bf16_t*)(ws + WS_WBD), MTOK, DM, 512};
        typedef pg8::StaticOrder<MTOK / 256, DM / 256, 1> SO; SO S; S.init(G, (int)blockIdx.x);
        pg8::EpiMerge E{(const bf16_t*)(ws + WS_G1), (const bf16_t*)(ws + WS_G2), (bf16_t*)(ws + WS_MIX)};
        pg8::gemm_phase<pg8::EpiMerge, SO, true, true>(lds, g, S, E);
    }
    SEAM(4);
    if (IN(5)) {
        pg8::Gemm g{(const bf16_t*)(ws + WS_MIX), (const bf16_t*)(ws + WS_MIX), (const bf16_t*)(ws + WS_WO), (const bf16_t*)(ws + WS_WO), MTOK, DM, DM};
        typedef pg8::StaticOrder<MTOK / 256, DM / 256, 0> SO; SO S; S.init(G, (int)blockIdx.x);
        typedef pg8::EpiResid<false, true> EP; EP E{x, (void*)(ws + WS_X1B), mod + 2 * DM};
        pg8::gemm_phase<EP, SO, true, true>(lds, g, S, E);
    }
    SEAM(5);
    if (IN(6)) norm_rows_bf((const bf16_t*)(ws + WS_X1B), args.in[19], mod, 3 * DM, 4 * DM, H, G);
    SEAM(6);
    if (IN(7)) {
        pg8::Gemm g{H, H, (const bf16_t*)(ws + WS_WF1), (const bf16_t*)(ws + WS_WF1), MTOK, 2 * FFH, DM};
        typedef pg8::StaticOrder<MTOK / 256, 2 * FFH / 256, 0> SO; SO S; S.init(G, (int)blockIdx.x);
        pg8::EpiSwiglu E{(bf16_t*)(ws + WS_ACT)};
        pg8::gemm_phase<pg8::EpiSwiglu, SO, true, true>(lds, g, S, E);
    }
    SEAM(7);
    if (IN(8)) {
        pg8::Gemm g{(const bf16_t*)(ws + WS_ACT), (const bf16_t*)(ws + WS_ACT), (const bf16_t*)(ws + WS_WF2), (const bf16_t*)(ws + WS_WF2), MTOK, DM, FFH};
        typedef pg8::StaticOrder<MTOK / 256, DM / 256, 0> SO; SO S; S.init(G, (int)blockIdx.x);
        typedef pg8::EpiResid<true, false> EP; EP E{(const void*)(ws + WS_X1B), (void*)args.out, mod + 5 * DM};
        pg8::gemm_phase<EP, SO, true, true>(lds, g, S, E);
    }
#undef IN
#undef SEAM
}

#ifndef MK_MULTI
#define MK_MULTI 0
#endif

extern "C" void kernel_launch(void* const* d_in, const int* in_sizes, int n_in, void* d_out, int out_size, void* d_ws, size_t ws_size, hipStream_t stream) {
    static int grid = 0;
    if (grid == 0) {
        if (n_in != 22 || out_size != MTOK * DM || ws_size < WS_END) { fprintf(stderr, "kernel_launch: unexpected shapes (n_in %d out %d ws %zu)\n", n_in, out_size, ws_size); grid = -1; return; }
        int dev = 0, cus = 0, per_cu = 0;
        (void)hipGetDevice(&dev);
        (void)hipDeviceGetAttribute(&cus, hipDeviceAttributeMultiprocessorCount, dev);
        if (hipFuncSetAttribute((const void*)fwd_kernel, hipFuncAttributeMaxDynamicSharedMemorySize, LDS_BYTES) != hipSuccess) { fprintf(stderr, "kernel_launch: hipFuncSetAttribute failed\n"); grid = -1; return; }
        if (hipOccupancyMaxActiveBlocksPerMultiprocessor(&per_cu, (const void*)fwd_kernel, 512, LDS_BYTES) != hipSuccess || per_cu < 1) { fprintf(stderr, "kernel_launch: occupancy query says %d\n", per_cu); per_cu = 1; }
        (void)hipGetLastError();
        grid = cus * 1;
        fprintf(stderr, "kernel_launch: grid %d (cus %d per_cu %d)\n", grid, cus, per_cu);
    }
    if (grid < 0) return;
    Args a{};
    for (int i = 0; i < 22; ++i) a.in[i] = (const float*)d_in[i];
    a.out = (float*)d_out; a.ws = (unsigned char*)d_ws;
#if MK_MULTI
    for (int p = 0; p < NPHASE; ++p) { a.ph_lo = p; a.ph_hi = p + 1; hipLaunchKernelGGL(fwd_kernel, dim3(grid), dim3(512), LDS_BYTES, stream, a); }
#else
    a.ph_lo = 0; a.ph_hi = NPHASE;
    (void)hipMemsetAsync((unsigned char*)d_ws + WS_BAR, 0, 16384, stream);
    void* kargs[] = {&a};
    hipError_t e = hipLaunchCooperativeKernel((const void*)fwd_kernel, dim3(grid), dim3(512), kargs, LDS_BYTES, stream);
    if (e != hipSuccess) fprintf(stderr, "kernel_launch: cooperative launch failed: %s (grid %d)\n", hipGetErrorString(e), grid);
#endif
}
```

```cpp
#include <hip/hip_runtime.h>
#include <hip/hip_cooperative_groups.h>
#include <cstdio>
#include <cstdint>
namespace cg = cooperative_groups;

#define LAS __attribute__((address_space(3)))
typedef unsigned short bf16_t;
typedef short bf16x8 __attribute__((ext_vector_type(8)));
typedef float f32x4 __attribute__((ext_vector_type(4)));
typedef float f32x16 __attribute__((ext_vector_type(16)));
typedef float f32x2 __attribute__((ext_vector_type(2)));
typedef unsigned u32x4 __attribute__((ext_vector_type(4)));
typedef unsigned u32x2 __attribute__((ext_vector_type(2)));
typedef __bf16 bf16x2_t __attribute__((ext_vector_type(2)));

__device__ __forceinline__ unsigned pk2(float lo, float hi) { f32x2 v = {lo, hi}; bf16x2_t b = __builtin_convertvector(v, bf16x2_t); return __builtin_bit_cast(unsigned, b); }
__device__ __forceinline__ float bf_lo(unsigned u) { return __uint_as_float(u << 16); }
__device__ __forceinline__ float bf_hi(unsigned u) { return __uint_as_float(u & 0xffff0000u); }
__device__ __forceinline__ float bf1(bf16_t u) { return __uint_as_float(((unsigned)u) << 16); }
__device__ __forceinline__ float sigmoidf_(float x) { return __builtin_amdgcn_rcpf(1.0f + __builtin_amdgcn_exp2f(x * -1.4426950408889634f)); }
__device__ __forceinline__ float siluf_(float x) { return x * __builtin_amdgcn_rcpf(1.0f + __builtin_amdgcn_exp2f(x * -1.4426950408889634f)); }
__device__ __forceinline__ int tid_fresh() { int t = threadIdx.x; asm volatile("" : "+v"(t)); return t; }
__device__ __forceinline__ int crow(int r, int hi) { return (r & 3) + 8 * (r >> 2) + 4 * hi; }
__device__ __forceinline__ float wave_sum(float v) {
#pragma unroll
    for (int o = 1; o < 64; o <<= 1) v += __shfl_xor(v, o);
    return v;
}

constexpr int BATCH = 16, SEQ = 4096, DM = 1024, MTOK = BATCH * SEQ;
constexpr int NMOD = 6 * DM;
constexpr int INCOLS = 5136;
constexpr int NA = 4352;
constexpr int FFH = 2816;
constexpr float EPS = 1e-6f;
constexpr float LOG2E = 1.4426950408889634f;
constexpr int C_GQ = 0, C_GK = 256, C_GV = 512, C_GR = 1024, C_GA = 1536, C_DQ = 1552, C_DK = 2064, C_DV = 2576, C_G1 = 3088, C_G2 = 4112;

constexpr size_t MiB = 1u << 20;
constexpr size_t WS_MOD = 0;
constexpr size_t WS_MISC = 512 * 1024;
constexpr size_t WS_BAR = 768 * 1024;
constexpr size_t WS_WA = 1 * MiB;
constexpr size_t WS_WV = 10 * MiB;
constexpr size_t WS_WBG = 12 * MiB;
constexpr size_t WS_WBD = 13 * MiB;
constexpr size_t WS_WO = 14 * MiB;
constexpr size_t WS_WF1 = 16 * MiB;
constexpr size_t WS_WF2 = 27 * MiB;
constexpr size_t WS_H = 40 * MiB;
constexpr size_t WS_GQ = 168 * MiB;
constexpr size_t WS_GK = 200 * MiB;
constexpr size_t WS_LA = 232 * MiB;
constexpr size_t WS_GR = 296 * MiB;
constexpr size_t WS_DQ = 360 * MiB;
constexpr size_t WS_DK = 424 * MiB;
constexpr size_t WS_G1 = 488 * MiB;
constexpr size_t WS_G2 = 616 * MiB;
constexpr size_t WS_VT = 744 * MiB;
constexpr size_t WS_OG = 872 * MiB;
constexpr size_t WS_OD = 936 * MiB;
constexpr size_t WS_X1B = 872 * MiB;
constexpr size_t WS_MIX = 168 * MiB;
constexpr size_t WS_ACT = 296 * MiB;
constexpr size_t WS_END = 1000 * MiB;

constexpr int LDS_BYTES = 147456;

namespace pg8 {
constexpr int BM = 256, BK = 64, HALF = 128, HTB = HALF * BK * 2, STAGE_BYTES = 8 * HTB, NXCD = 8, WGM = 8;
__host__ __device__ __forceinline__ int lds_byte(int r, int c) { const int st = (r >> 4) * 2 + (c >> 5), rr = r & 15, cc = c & 31, ob = rr * 64 + cc * 2; return st * 1024 + (ob ^ (((ob >> 9) & 1) << 5)); }
__host__ __device__ __forceinline__ void stage_rc(int b, int& R, int& C) { const int st = b / 1024, sb = b % 1024, swz = sb ^ (((sb >> 9) & 1) << 5); R = (st >> 1) * 16 + swz / 64; C = (st & 1) * 32 + (swz % 64) / 2; }
__host__ __device__ __forceinline__ int perm32(int rho) { const int n = rho >> 4, i = rho & 15; return 8 * (i >> 2) + 4 * n + (i & 3); }
__host__ __device__ __forceinline__ int permV(int rho) { const int n = rho >> 4, fq = (rho >> 2) & 3, j = rho & 3; return 16 * (fq >> 1) + 8 * n + 4 * (fq & 1) + j; }

struct Unit { int pm, pn, seg; };
struct Gemm { const bf16_t* A0; const bf16_t* A1; const bf16_t* B0; const bf16_t* B1; int M, N, K; };

template <int NM, int NN, int DUALV>
struct StaticOrder {
    int G, c;
    __device__ void init(int G_, int c_) { G = G_; c = c_; }
    __device__ bool next(int i, Unit& u) const {
        constexpr int nwg = NM * NN, q = nwg / NXCD, r = nwg % NXCD, nig = WGM * NN;
        const int it = DUALV ? (i >> 1) : i;
        const long L = (long)it * G + c; if (L >= nwg) return false;
        int wgid = (int)L; { const int xcd = wgid % NXCD, off = wgid / NXCD; wgid = (xcd < r ? xcd * (q + 1) : r * (q + 1) + (xcd - r) * q) + off; }
        const int gid = wgid / nig, fm = gid * WGM, rem = wgid % nig;
        if constexpr (NM % WGM == 0) { u.pm = fm + (rem % WGM); u.pn = rem / WGM; }
        else { const int gsz = (NM - fm) < WGM ? (NM - fm) : WGM; u.pm = fm + (rem % gsz); u.pn = rem / gsz; }
        u.seg = DUALV ? (i & 1) : 0; return true;
    }
};

template <class Epi, class Sched, bool ALIGN_EPI, bool SP2>
__device__ __forceinline__ void gemm_phase(LAS unsigned char* lds, const Gemm g, const Sched& S, const Epi& E) {
    const int tid = tid_fresh(), wid = __builtin_amdgcn_readfirstlane(tid >> 6), lane = tid & 63, wr = wid >> 2, wc = wid & 3, fr = lane & 15, fq = lane >> 4;
    const int K = g.K, nt = K / BK;
    unsigned voffA[2], voffB[2];
#pragma unroll
    for (int i = 0; i < 2; ++i) { int R, C; stage_rc(tid * 16 + i * 8192, R, C); const int Rb = (Epi::PERM == 2) ? ((R & ~31) + permV(R & 31)) : (Epi::PERM == 1) ? ((R & ~31) + perm32(R & 31)) : R;
        voffA[i] = (unsigned)(R * K + C) * 2u; voffB[i] = (unsigned)(Rb * K + C) * 2u; }
    const size_t kstep = (size_t)(BK * 2);
    const size_t hstep = (size_t)HALF * K * 2;
    const size_t tstep = 2 * hstep;
    const unsigned ldsw = (unsigned)wid * 1024u;
    const int aoff = lds_byte(wr * 64 + fr, fq * 8), boff = lds_byte(wc * 32 + fr, fq * 8);
#define PG8_SA(b, h) (((b) * 2 + (h)) * HTB)
#define PG8_SB(b, h) ((4 + (b) * 2 + (h)) * HTB)
#define PG8_STAGE(bufoff, gbase, voff) do { _Pragma("unroll") for (int _i = 0; _i < 2; ++_i) \
        __builtin_amdgcn_global_load_lds((const unsigned*)((const char*)(gbase) + (voff)[_i]), (LAS unsigned*)(lds + (bufoff) + ldsw + _i * 8192), 16, 0, 0); } while (0)
#define PG8_LDA(dst, b, h) do { _Pragma("unroll") for (int m = 0; m < 4; ++m) _Pragma("unroll") for (int k = 0; k < 2; ++k) dst[m][k] = *(const LAS bf16x8*)(lds + PG8_SA(b, h) + aoff + m * 2048 + k * 1024); } while (0)
#define PG8_LDB(dst, b, h) do { _Pragma("unroll") for (int n = 0; n < 2; ++n) _Pragma("unroll") for (int k = 0; k < 2; ++k) dst[n][k] = *(const LAS bf16x8*)(lds + PG8_SB(b, h) + boff + n * 2048 + k * 1024); } while (0)
#define PG8_MMA(ai, bj, At, Bt) do { __builtin_amdgcn_s_setprio(1); _Pragma("unroll") for (int m = 0; m < 4; ++m) _Pragma("unroll") for (int n = 0; n < 2; ++n) _Pragma("unroll") for (int k = 0; k < 2; ++k) \
        acc[ai][bj][m][n] = __builtin_amdgcn_mfma_f32_16x16x32_bf16(Bt[n][k], At[m][k], acc[ai][bj][m][n], 0, 0, 0); __builtin_amdgcn_s_setprio(0); } while (0)
#define PG8_WAIT_V(n) asm volatile("s_waitcnt vmcnt(" #n ")" ::: "memory")
#define PG8_WAIT_L(n) asm volatile("s_waitcnt lgkmcnt(" #n ")" ::: "memory")
#define PG8_BAR __builtin_amdgcn_s_barrier()
#define PG8_SCHED __builtin_amdgcn_sched_barrier(0)
    Unit cur, nxt; int ui = 0;
    if (!S.next(0, cur)) return;
    f32x4 acc[2][2][4][2];
#pragma unroll
    for (int a = 0; a < 2; ++a)
#pragma unroll
        for (int b = 0; b < 2; ++b)
#pragma unroll
            for (int m = 0; m < 4; ++m)
#pragma unroll
                for (int n = 0; n < 2; ++n) acc[a][b][m][n] = (f32x4){0.f, 0.f, 0.f, 0.f};
    bf16x8 At[4][2], B0[2][2], B1[2][2];
    const char* cA = (const char*)(cur.seg ? g.A1 : g.A0) + (size_t)cur.pm * tstep; const char* cB = (const char*)(cur.seg ? g.B1 : g.B0) + (size_t)cur.pn * tstep;
    if constexpr (SP2) {
        PG8_STAGE(PG8_SB(0, 0), cB, voffB); PG8_STAGE(PG8_SB(0, 1), cB + hstep, voffB); PG8_STAGE(PG8_SA(0, 0), cA, voffA); PG8_STAGE(PG8_SA(0, 1), cA + hstep, voffA);
        if (wr == 1) PG8_BAR;
        PG8_WAIT_V(2); PG8_BAR;
        PG8_STAGE(PG8_SB(1, 0), cB + kstep, voffB); PG8_STAGE(PG8_SA(1, 0), cA + kstep, voffA); PG8_STAGE(PG8_SB(1, 1), cB + hstep + kstep, voffB);
        PG8_WAIT_V(6); PG8_BAR;
    } else {
        PG8_STAGE(PG8_SB(0, 0), cB, voffB); PG8_STAGE(PG8_SA(0, 0), cA, voffA); PG8_STAGE(PG8_SB(0, 1), cB + hstep, voffB); PG8_STAGE(PG8_SA(0, 1), cA + hstep, voffA);
        if (wr == 1) PG8_BAR;
        PG8_WAIT_V(4); PG8_BAR;
        PG8_STAGE(PG8_SB(1, 0), cB + kstep, voffB); PG8_STAGE(PG8_SA(1, 0), cA + kstep, voffA); PG8_STAGE(PG8_SB(1, 1), cB + hstep + kstep, voffB);
        PG8_WAIT_V(6); PG8_BAR;
    }
    for (;;) {
        const bool has_next = S.next(ui + 1, nxt);
        const char* nA = has_next ? (const char*)(nxt.seg ? g.A1 : g.A0) + (size_t)nxt.pm * tstep : cA; const char* nB = has_next ? (const char*)(nxt.seg ? g.B1 : g.B0) + (size_t)nxt.pn * tstep : cB;
        for (int t = 0; t < nt; t += 2) {
            const bool last = (t == nt - 2);
            const char* a1 = cA + (size_t)(t + 1) * kstep;
            const char* a2 = last ? nA : cA + (size_t)(t + 2) * kstep; const char* b2 = last ? nB : cB + (size_t)(t + 2) * kstep;
            const char* a3 = a2 + kstep; const char* b3 = b2 + kstep;
            if constexpr (SP2) {
            PG8_LDB(B0, 0, 0); PG8_LDB(B1, 0, 1); PG8_SCHED; PG8_LDA(At, 0, 0); PG8_STAGE(PG8_SA(1, 1), a1 + hstep, voffA);
            PG8_WAIT_V(8); PG8_WAIT_L(0); PG8_BAR; PG8_MMA(0, 0, At, B0); PG8_MMA(0, 1, At, B1); PG8_BAR; PG8_SCHED;
            PG8_LDA(At, 0, 1); PG8_STAGE(PG8_SB(0, 0), b2, voffB); PG8_STAGE(PG8_SB(0, 1), b2 + hstep, voffB); PG8_STAGE(PG8_SA(0, 0), a2, voffA);
            PG8_WAIT_V(8); PG8_WAIT_L(0); PG8_BAR; PG8_MMA(1, 0, At, B0); PG8_MMA(1, 1, At, B1); PG8_BAR; PG8_SCHED;
            PG8_LDB(B0, 1, 0); PG8_LDB(B1, 1, 1); PG8_SCHED; PG8_LDA(At, 1, 0); PG8_STAGE(PG8_SA(0, 1), a2 + hstep, voffA);
            PG8_WAIT_V(8); PG8_WAIT_L(0); PG8_BAR; PG8_MMA(0, 0, At, B0); PG8_MMA(0, 1, At, B1); PG8_BAR; PG8_SCHED;
            PG8_LDA(At, 1, 1); PG8_STAGE(PG8_SB(1, 0), b3, voffB); PG8_STAGE(PG8_SB(1, 1), b3 + hstep, voffB); PG8_STAGE(PG8_SA(1, 0), a3, voffA);
            PG8_WAIT_V(8); PG8_WAIT_L(0); PG8_BAR; PG8_MMA(1, 0, At, B0); PG8_MMA(1, 1, At, B1); PG8_BAR; PG8_SCHED;
            } else {
            PG8_LDB(B0, 0, 0); PG8_SCHED; PG8_LDA(At, 0, 0); PG8_STAGE(PG8_SA(1, 1), a1 + hstep, voffA);
            PG8_WAIT_L(8); PG8_BAR; PG8_WAIT_L(0); PG8_MMA(0, 0, At, B0); PG8_BAR; PG8_SCHED;
            PG8_LDB(B1, 0, 1); PG8_STAGE(PG8_SB(0, 0), b2, voffB);
            PG8_BAR; PG8_WAIT_L(0); PG8_MMA(0, 1, At, B1); PG8_BAR;
            PG8_LDA(At, 0, 1); PG8_STAGE(PG8_SA(0, 0), a2, voffA);
            PG8_BAR; PG8_WAIT_L(0); PG8_MMA(1, 0, At, B0); PG8_BAR; PG8_SCHED;
            PG8_STAGE(PG8_SB(0, 1), b2 + hstep, voffB);
            PG8_WAIT_V(6); PG8_BAR; PG8_MMA(1, 1, At, B1); PG8_BAR;
            PG8_LDB(B0, 1, 0); PG8_SCHED; PG8_LDA(At, 1, 0); PG8_STAGE(PG8_SA(0, 1), a2 + hstep, voffA);
            PG8_WAIT_L(8); PG8_BAR; PG8_WAIT_L(0); PG8_MMA(0, 0, At, B0); PG8_BAR; PG8_SCHED;
            PG8_LDB(B1, 1, 1); PG8_STAGE(PG8_SB(1, 0), b3, voffB);
            PG8_BAR; PG8_WAIT_L(0); PG8_MMA(0, 1, At, B1); PG8_BAR;
            PG8_LDA(At, 1, 1); PG8_STAGE(PG8_SA(1, 0), a3, voffA);
            PG8_BAR; PG8_WAIT_L(0); PG8_MMA(1, 0, At, B0); PG8_BAR; PG8_SCHED;
            PG8_STAGE(PG8_SB(1, 1), b3 + hstep, voffB);
            PG8_WAIT_V(6); PG8_BAR; PG8_MMA(1, 1, At, B1); PG8_BAR;
            }
        }
        if constexpr (ALIGN_EPI) { if (wr == 0) PG8_BAR; }
        bool keep = false;
        if constexpr (Epi::DUAL) { if (cur.seg == 0) { E.mid(acc, cur, wr, wc, fr, fq); keep = true; } }
        if (!keep) E(acc, cur, wr, wc, fr, fq);
        if (!has_next) break;
        if (!keep) {
#pragma unroll
        for (int a = 0; a < 2; ++a)
#pragma unroll
            for (int b = 0; b < 2; ++b)
#pragma unroll
                for (int m = 0; m < 4; ++m)
#pragma unroll
                    for (int n = 0; n < 2; ++n) acc[a][b][m][n] = (f32x4){0.f, 0.f, 0.f, 0.f};
        }
        cur = nxt; cA = nA; cB = nB; ++ui;
        if constexpr (ALIGN_EPI) { if (wr == 1) PG8_BAR; }
    }
    PG8_WAIT_V(0);
    if constexpr (!ALIGN_EPI) { if (wr == 0) PG8_BAR; }
    PG8_BAR;
#undef PG8_SA
#undef PG8_SB
#undef PG8_STAGE
#undef PG8_LDA
#undef PG8_LDB
#undef PG8_MMA
#undef PG8_WAIT_V
#undef PG8_WAIT_L
#undef PG8_BAR
#undef PG8_SCHED
}

typedef f32x4 AccT[2][2][4][2];

struct EpiInA {
    static constexpr int PERM = 1; static constexpr bool DUAL = false;
    bf16_t *GQ, *GK, *GR, *DQ, *DK, *G1, *G2; float* LA; const float *b_alpha, *gain_q, *gain_k;
    __device__ __forceinline__ void operator()(const AccT& acc, const Unit& u, int wr, int wc, int fr, int fq) const {
        const int pn = u.pn; const int row0 = u.pm * BM + wr * 64 + fr;
        if (pn == 2) {
#pragma unroll
            for (int bj = 0; bj < 2; ++bj) { const int c = bj * HALF + wc * 32 + 8 * fq;
                const f32x4 b0 = *(const f32x4*)(b_alpha + c), b1 = *(const f32x4*)(b_alpha + c + 4);
#pragma unroll
                for (int ai = 0; ai < 2; ++ai)
#pragma unroll
                    for (int m = 0; m < 4; ++m) { float* p = LA + (size_t)(row0 + ai * HALF + m * 16) * 256 + c;
                        f32x4 v0 = acc[ai][bj][m][0] + b0, v1 = acc[ai][bj][m][1] + b1, o0, o1;
#pragma unroll
                        for (int j = 0; j < 4; ++j) { o0[j] = (fminf(v0[j], 0.f) - __logf(1.f + __expf(-fabsf(v0[j])))) * 0.0625f; o1[j] = (fminf(v1[j], 0.f) - __logf(1.f + __expf(-fabsf(v1[j])))) * 0.0625f; }
                        *(f32x4*)p = o0; *(f32x4*)(p + 4) = o1; } }
            return;
        }
        if (pn >= 5 && pn < 9) {
            const bool isq = pn < 7; bf16_t* dst = isq ? DQ : DK; const float* gain = isq ? gain_q : gain_k; const int cb = (isq ? pn - 5 : pn - 7) * 256 + 64 * wc;
            const float osc = isq ? 0.125f * LOG2E : 1.0f;
            f32x4 gv[2][2];
#pragma unroll
            for (int bj = 0; bj < 2; ++bj)
#pragma unroll
                for (int n = 0; n < 2; ++n) gv[bj][n] = *(const f32x4*)(gain + 32 * bj + 8 * fq + 4 * n);
#pragma unroll
            for (int ai = 0; ai < 2; ++ai)
#pragma unroll
                for (int m = 0; m < 4; ++m) { float ss = 0.f;
#pragma unroll
                    for (int bj = 0; bj < 2; ++bj)
#pragma unroll
                        for (int n = 0; n < 2; ++n) { const f32x4 x = acc[ai][bj][m][n]; ss += (x[0] * x[0] + x[1] * x[1]) + (x[2] * x[2] + x[3] * x[3]); }
                    ss += __shfl_xor(ss, 16); ss += __shfl_xor(ss, 32);
                    const float rn = __builtin_amdgcn_rsqf(ss * (1.0f / 64.0f) + EPS) * osc;
                    bf16_t* p = dst + (size_t)(row0 + ai * HALF + m * 16) * 512 + cb + 8 * fq;
#pragma unroll
                    for (int bj = 0; bj < 2; ++bj) { const f32x4 v0 = acc[ai][bj][m][0] * rn * gv[bj][0], v1 = acc[ai][bj][m][1] * rn * gv[bj][1];
                        u32x4 w; w.x = pk2(v0[0], v0[1]); w.y = pk2(v0[2], v0[3]); w.z = pk2(v1[0], v1[1]); w.w = pk2(v1[2], v1[3]);
                        *(u32x4*)(p + 32 * bj) = w; } }
            return;
        }
        int mode, ldc, cb; bf16_t* dst;
        float sc = 1.f;
        if (pn == 0) { mode = 0; dst = GQ; ldc = 256; cb = 0; sc = 0.125f; }
        else if (pn == 1) { mode = 0; dst = GK; ldc = 256; cb = 0; }
        else if (pn < 5) { mode = 1; dst = GR; ldc = 512; cb = (pn - 3) * 256; }
        else if (pn < 13) { mode = 2; dst = G1; ldc = 1024; cb = (pn - 9) * 256; }
        else { mode = 2; dst = G2; ldc = 1024; cb = (pn - 13) * 256; }
#pragma unroll
        for (int ai = 0; ai < 2; ++ai)
#pragma unroll
            for (int m = 0; m < 4; ++m) { bf16_t* p = dst + (size_t)(row0 + ai * HALF + m * 16) * ldc + cb + wc * 32 + 8 * fq;
#pragma unroll
                for (int bj = 0; bj < 2; ++bj) { f32x4 v0 = acc[ai][bj][m][0], v1 = acc[ai][bj][m][1];
                    if (mode == 0) { v0 = v0 * sc; v1 = v1 * sc; }
                    else if (mode == 1) {
#pragma unroll
                        for (int j = 0; j < 4; ++j) { v0[j] = siluf_(v0[j]); v1[j] = siluf_(v1[j]); } }
                    else {
#pragma unroll
                        for (int j = 0; j < 4; ++j) { v0[j] = sigmoidf_(v0[j]); v1[j] = sigmoidf_(v1[j]); } }
                    u32x4 w; w.x = pk2(v0[0], v0[1]); w.y = pk2(v0[2], v0[3]); w.z = pk2(v1[0], v1[1]); w.w = pk2(v1[2], v1[3]);
                    *(u32x4*)(p + bj * HALF) = w; } }
    }
};

struct EpiInV {
    static constexpr int PERM = 2; static constexpr bool DUAL = false;
    bf16_t* VT;
    __device__ __forceinline__ void operator()(const AccT& acc, const Unit& u, int wr, int wc, int fr, int fq) const {
        const int ch0 = u.pm * BM + wr * 64 + fr; const int tok0 = u.pn * BM + wc * 32 + 8 * fq; const int b = tok0 >> 12, s0 = tok0 & 4095;
#pragma unroll
        for (int ai = 0; ai < 2; ++ai)
#pragma unroll
            for (int m = 0; m < 4; ++m) { bf16_t* p = VT + ((size_t)b * 1024 + ch0 + ai * HALF + m * 16) * SEQ + s0;
#pragma unroll
                for (int bj = 0; bj < 2; ++bj) { const f32x4 v0 = acc[ai][bj][m][0], v1 = acc[ai][bj][m][1];
                    u32x4 w; w.x = pk2(v0[0], v0[1]); w.y = pk2(v0[2], v0[3]); w.z = pk2(v1[0], v1[1]); w.w = pk2(v1[2], v1[3]);
                    *(u32x4*)(p + bj * HALF) = w; } }
    }
};

struct EpiMerge {
    static constexpr int PERM = 1; static constexpr bool DUAL = true;
    const bf16_t *G1, *G2; bf16_t* MIX;
    __device__ __forceinline__ void mid(AccT& acc, const Unit& u, int wr, int wc, int fr, int fq) const {
        const size_t off0 = (size_t)(u.pm * BM + wr * 64 + fr) * 1024 + u.pn * BM + wc * 32 + 8 * fq;
#pragma unroll
        for (int ai = 0; ai < 2; ++ai)
#pragma unroll
            for (int m = 0; m < 4; ++m)
#pragma unroll
                for (int bj = 0; bj < 2; ++bj) { const size_t off = off0 + (size_t)(ai * HALF + m * 16) * 1024 + bj * HALF;
                    const u32x4 a = *(const u32x4*)(G1 + off), b = *(const u32x4*)(G2 + off);
                    f32x4 r0, r1;
                    r0[0] = bf_lo(a.x) * __builtin_amdgcn_rcpf(bf_lo(b.x)); r0[1] = bf_hi(a.x) * __builtin_amdgcn_rcpf(bf_hi(b.x));
                    r0[2] = bf_lo(a.y) * __builtin_amdgcn_rcpf(bf_lo(b.y)); r0[3] = bf_hi(a.y) * __builtin_amdgcn_rcpf(bf_hi(b.y));
                    r1[0] = bf_lo(a.z) * __builtin_amdgcn_rcpf(bf_lo(b.z)); r1[1] = bf_hi(a.z) * __builtin_amdgcn_rcpf(bf_hi(b.z));
                    r1[2] = bf_lo(a.w) * __builtin_amdgcn_rcpf(bf_lo(b.w)); r1[3] = bf_hi(a.w) * __builtin_amdgcn_rcpf(bf_hi(b.w));
                    acc[ai][bj][m][0] = acc[ai][bj][m][0] * r0; acc[ai][bj][m][1] = acc[ai][bj][m][1] * r1; }
    }
    __device__ __forceinline__ void operator()(const AccT& acc, const Unit& u, int wr, int wc, int fr, int fq) const {
        const size_t off0 = (size_t)(u.pm * BM + wr * 64 + fr) * 1024 + u.pn * BM + wc * 32 + 8 * fq;
#pragma unroll
        for (int ai = 0; ai < 2; ++ai)
#pragma unroll
            for (int m = 0; m < 4; ++m)
#pragma unroll
                for (int bj = 0; bj < 2; ++bj) { const size_t off = off0 + (size_t)(ai * HALF + m * 16) * 1024 + bj * HALF;
                    const u32x4 b = *(const u32x4*)(G2 + off);
                    const f32x4 v0 = acc[ai][bj][m][0], v1 = acc[ai][bj][m][1];
                    u32x4 w; w.x = pk2(v0[0] * bf_lo(b.x), v0[1] * bf_hi(b.x)); w.y = pk2(v0[2] * bf_lo(b.y), v0[3] * bf_hi(b.y));
                    w.z = pk2(v1[0] * bf_lo(b.z), v1[1] * bf_hi(b.z)); w.w = pk2(v1[2] * bf_lo(b.w), v1[3] * bf_hi(b.w));
                    *(u32x4*)(MIX + off) = w; }
    }
};

template <bool BB, bool OB>
struct EpiResid {
    static constexpr int PERM = 1; static constexpr bool DUAL = false;
    const void* base; void* out; const float* gate;
    __device__ __forceinline__ void operator()(const AccT& acc, const Unit& u, int wr, int wc, int fr, int fq) const {
        const int row0 = u.pm * BM + wr * 64 + fr; const int col0 = u.pn * BM + wc * 32 + 8 * fq; const int b = row0 >> 12;
        f32x4 gt[2][2];
#pragma unroll
        for (int bj = 0; bj < 2; ++bj)
#pragma unroll
            for (int n = 0; n < 2; ++n) gt[bj][n] = *(const f32x4*)(gate + (size_t)b * NMOD + col0 + bj * HALF + n * 4);
#pragma unroll
        for (int ai = 0; ai < 2; ++ai)
#pragma unroll
            for (int m = 0; m < 4; ++m) { const size_t off = (size_t)(row0 + ai * HALF + m * 16) * DM + col0;
#pragma unroll
                for (int bj = 0; bj < 2; ++bj) { f32x4 b0, b1;
                    if constexpr (BB) { const u32x4 w = *(const u32x4*)((const bf16_t*)base + off + bj * HALF);
                        b0 = (f32x4){bf_lo(w.x), bf_hi(w.x), bf_lo(w.y), bf_hi(w.y)}; b1 = (f32x4){bf_lo(w.z), bf_hi(w.z), bf_lo(w.w), bf_hi(w.w)}; }
                    else { b0 = __builtin_nontemporal_load((const f32x4*)((const float*)base + off + bj * HALF)); b1 = __builtin_nontemporal_load((const f32x4*)((const float*)base + off + bj * HALF + 4)); }
                    const f32x4 o0 = b0 + gt[bj][0] * acc[ai][bj][m][0], o1 = b1 + gt[bj][1] * acc[ai][bj][m][1];
                    if constexpr (OB) { u32x4 w; w.x = pk2(o0[0], o0[1]); w.y = pk2(o0[2], o0[3]); w.z = pk2(o1[0], o1[1]); w.w = pk2(o1[2], o1[3]);
                        *(u32x4*)((bf16_t*)out + off + bj * HALF) = w; }
                    else { __builtin_nontemporal_store(o0, (f32x4*)((float*)out + off + bj * HALF)); __builtin_nontemporal_store(o1, (f32x4*)((float*)out + off + bj * HALF + 4)); } } }
    }
};

struct EpiSwiglu {
    static constexpr int PERM = 1; static constexpr bool DUAL = false;
    bf16_t* ACT;
    __device__ __forceinline__ void operator()(const AccT& acc, const Unit& u, int wr, int wc, int fr, int fq) const {
        const int row0 = u.pm * BM + wr * 64 + fr; const int col0 = u.pn * HALF + wc * 32 + 8 * fq;
#pragma unroll
        for (int ai = 0; ai < 2; ++ai)
#pragma unroll
            for (int m = 0; m < 4; ++m) { const f32x4 g0 = acc[ai][0][m][0], g1 = acc[ai][0][m][1], u0 = acc[ai][1][m][0], u1 = acc[ai][1][m][1];
                f32x4 o0, o1;
#pragma unroll
                for (int j = 0; j < 4; ++j) { o0[j] = siluf_(g0[j]) * u0[j]; o1[j] = siluf_(g1[j]) * u1[j]; }
                u32x4 w; w.x = pk2(o0[0], o0[1]); w.y = pk2(o0[2], o0[3]); w.z = pk2(o1[0], o1[1]); w.w = pk2(o1[2], o1[3]);
                *(u32x4*)(ACT + (size_t)(row0 + ai * HALF + m * 16) * FFH + col0) = w; }
    }
};
}

__device__ __forceinline__ void tr_item(const float* __restrict__ W, int ldw, int c0, int k0, bf16_t* __restrict__ WT, int K, int dst0, LAS float* scr, int lane) {
#pragma unroll
    for (int i = 0; i < 32; ++i) { const int kk = 2 * i + (lane >> 5); scr[kk * 33 + (lane & 31)] = __builtin_nontemporal_load(W + (size_t)(k0 + kk) * ldw + c0 + (lane & 31)); }
    asm volatile("s_waitcnt lgkmcnt(0)" ::: "memory");
    const int c = lane & 7;
#pragma unroll
    for (int j = 0; j < 4; ++j) { const int n = (lane >> 3) + 8 * j; const LAS float* s = scr + (8 * c) * 33 + n;
        u32x4 o; o.x = pk2(s[0 * 33], s[1 * 33]); o.y = pk2(s[2 * 33], s[3 * 33]); o.z = pk2(s[4 * 33], s[5 * 33]); o.w = pk2(s[6 * 33], s[7 * 33]);
        *(u32x4*)(WT + (size_t)(dst0 + n) * K + k0 + 8 * c) = o; }
    asm volatile("s_waitcnt lgkmcnt(0)" ::: "memory");
}

struct Args {
    const float* in[22]; float* out; unsigned char* ws; int ph_lo, ph_hi;
};

__device__ __forceinline__ int wa_src(int nb) {
    const int t = nb >> 3, q = nb & 7;
    if (t == 0) return C_GQ + 32 * q;
    if (t == 1) return C_GK + 32 * q;
    if (t == 2) return -1;
    if (t < 5) return C_GR + (t - 3) * 256 + 32 * q;
    if (t < 9) { const int base = (t < 7) ? C_DQ + (t - 5) * 256 : C_DK + (t - 7) * 256; const int bj = q >> 2, wc = q & 3; return base + 64 * wc + 32 * bj; }
    if (t < 13) return C_G1 + (t - 9) * 256 + 32 * q;
    return C_G2 + (t - 13) * 256 + 32 * q;
}

__device__ __forceinline__ void phase0(const Args& a, LAS unsigned char* lds, int G) {
    const int tid = tid_fresh(), lane = tid & 63, wid = __builtin_amdgcn_readfirstlane(tid >> 6);
    unsigned char* ws = a.ws;
    const float* c_in = a.in[1]; const float* w_ada = a.in[2]; const float* b_ada = a.in[3];
    const float* w_in = a.in[5]; const float* w_up = a.in[6];
    float* mod = (float*)(ws + WS_MOD);
    if (blockIdx.x == 0 && tid < 64) {
        const float* lq1 = a.in[11]; const float* lk1 = a.in[12]; const float* lq2 = a.in[13]; const float* lk2 = a.in[14];
        const float s1 = wave_sum(lq1[lane] * lk1[lane]), s2 = wave_sum(lq2[lane] * lk2[lane]);
        if (lane < 16) ((unsigned*)(ws + WS_MISC))[8 + lane] = 0u;
        if (lane == 0) { ((unsigned*)(ws + WS_MISC))[0] = 0u; ((unsigned*)(ws + WS_MISC))[2] = 0u; ((float*)(ws + WS_MISC))[1] = __expf(s1) - __expf(s2) + 0.2f; }
    }
    if ((int)blockIdx.x < NMOD / 64) {
        LAS float* scT = (LAS float*)lds;
        LAS float* red = (LAS float*)(lds + 65536);
        for (int idx = tid; idx < 16 * 1024; idx += 512) { const int b = idx >> 10, k = idx & 1023; scT[k * 16 + b] = siluf_(c_in[idx]); }
        __syncthreads();
        const int n0 = blockIdx.x * 64;
        float acc[16];
#pragma unroll
        for (int b = 0; b < 16; ++b) acc[b] = 0.f;
        const float* wp = w_ada + (size_t)(wid * 128) * NMOD + n0 + lane;
#pragma unroll 8
        for (int k = 0; k < 128; ++k) { const float wv = wp[(size_t)k * NMOD]; const LAS f32x4* s4 = (const LAS f32x4*)(scT + (wid * 128 + k) * 16);
#pragma unroll
            for (int q = 0; q < 4; ++q) { const f32x4 s = s4[q]; acc[4 * q] += s[0] * wv; acc[4 * q + 1] += s[1] * wv; acc[4 * q + 2] += s[2] * wv; acc[4 * q + 3] += s[3] * wv; } }
#pragma unroll
        for (int b = 0; b < 16; ++b) red[(wid * 16 + b) * 64 + lane] = acc[b];
        __syncthreads();
        for (int o = tid; o < 1024; o += 512) { const int b = o >> 6, l = o & 63; float s = b_ada[n0 + l];
#pragma unroll
            for (int w = 0; w < 8; ++w) s += red[(w * 16 + b) * 64 + l];
            mod[(size_t)b * NMOD + n0 + l] = s; }
        __syncthreads();
    }
    LAS float* scr = (LAS float*)(lds + wid * 16384);
    const int NADA = (G > NMOD / 64) ? NMOD / 64 : G;
    const bool isada = (int)blockIdx.x < NADA;
    const int nslot = isada ? 1 : 2;
    const int slot0 = isada ? 2 * (G - NADA) * 8 + (int)blockIdx.x * 8 + wid : 2 * (((int)blockIdx.x - NADA) * 8 + wid);
    const int NSLOT = 2 * (G - NADA) * 8 + NADA * 8;
    bf16_t* WA = (bf16_t*)(ws + WS_WA); bf16_t* WV = (bf16_t*)(ws + WS_WV); bf16_t* WBG = (bf16_t*)(ws + WS_WBG); bf16_t* WBD = (bf16_t*)(ws + WS_WBD);
    bf16_t* WO = (bf16_t*)(ws + WS_WO); bf16_t* WF1 = (bf16_t*)(ws + WS_WF1); bf16_t* WF2 = (bf16_t*)(ws + WS_WF2);
    constexpr int I_A = 136 * 16, I_V = 32 * 16, I_BG = 32 * 8, I_BD = 32 * 8, I_O = 32 * 16, I_F1 = 176 * 16, I_F2 = 32 * 44;
    constexpr int NITEMS = I_A + I_V + I_BG + I_BD + I_O + I_F1 + I_F2;
    for (int itb = 0; itb < NITEMS; itb += NSLOT) for (int sl = 0; sl < nslot; ++sl) {
        const int it = itb + slot0 + sl; if (it >= NITEMS) continue;
        int r = it;
        if (r < I_A) { const int nb = r >> 4, kb = r & 15; const int src = wa_src(nb); if (src >= 0) tr_item(w_in, INCOLS, src, 64 * kb, WA, 1024, 32 * nb, scr, lane); continue; } r -= I_A;
        if (r < I_V) { const int nb = r >> 4, kb = r & 15; const int src = (nb < 16) ? C_GV + 32 * nb : C_DV + 32 * (nb - 16); tr_item(w_in, INCOLS, src, 64 * kb, WV, 1024, 32 * nb, scr, lane); continue; } r -= I_V;
        if (r < I_BG) { const int nb = r >> 3, kb = r & 7; tr_item(a.in[16], 1024, 32 * nb, 64 * kb, WBG, 512, 32 * nb, scr, lane); continue; } r -= I_BG;
        if (r < I_BD) { const int nb = r >> 3, kb = r & 7; tr_item(a.in[17], 1024, 32 * nb, 64 * kb, WBD, 512, 32 * nb, scr, lane); continue; } r -= I_BD;
        if (r < I_O) { const int nb = r >> 4, kb = r & 15; tr_item(a.in[18], 1024, 32 * nb, 64 * kb, WO, 1024, 32 * nb, scr, lane); continue; } r -= I_O;
        if (r < I_F1) { const int nb = r >> 4, kb = r & 15; const int t = nb >> 3, q = nb & 7; const int src = (q >> 2) * FFH + 128 * t + 32 * (q & 3);
            tr_item(a.in[20], 2 * FFH, src, 64 * kb, WF1, 1024, 32 * nb, scr, lane); continue; } r -= I_F1;
        { const int nb = r / 44, kb = r % 44; tr_item(a.in[21], 1024, 32 * nb, 64 * kb, WF2, FFH, 32 * nb, scr, lane); }
    }
    for (int i = blockIdx.x * 512 + tid; i < 256 * 128; i += G * 512) {
        const int j = i & 255, k0 = (i >> 8) * 8;
        float up[16];
#pragma unroll
        for (int r = 0; r < 16; ++r) up[r] = w_up[r * 256 + j];
        float o[8];
#pragma unroll
        for (int e = 0; e < 8; ++e) { const float* wr_ = w_in + (size_t)(k0 + e) * INCOLS + C_GA; float s = 0.f;
#pragma unroll
            for (int r = 0; r < 16; ++r) s += wr_[r] * up[r];
            o[e] = s; }
        u32x4 w; w.x = pk2(o[0], o[1]); w.y = pk2(o[2], o[3]); w.z = pk2(o[4], o[5]); w.w = pk2(o[6], o[7]);
        *(u32x4*)(WA + (size_t)(512 + j) * 1024 + k0) = w;
    }
}

__device__ __forceinline__ void norm_rows(const float* __restrict__ X, const float* __restrict__ g, const float* __restrict__ mod, int sh_off, int sc_off, bf16_t* __restrict__ H, int G) {
    const int tid = tid_fresh(), lane = tid & 63, wid = tid >> 6;
    const int gw = blockIdx.x * 8 + wid, NGW = G * 8;
    for (int row0 = gw; row0 < MTOK; row0 += 2 * NGW) {
        f32x4 v[2][4]; float ss[2] = {0.f, 0.f};
#pragma unroll
        for (int q = 0; q < 2; ++q) { const int rq = (row0 + q * NGW < MTOK) ? row0 + q * NGW : row0; const f32x4* xr = (const f32x4*)(X + (size_t)rq * DM) + lane;
#pragma unroll
            for (int j = 0; j < 4; ++j) v[q][j] = __builtin_nontemporal_load(xr + 64 * j); }
#pragma unroll
        for (int q = 0; q < 2; ++q)
#pragma unroll
            for (int j = 0; j < 4; ++j) ss[q] += (v[q][j][0] * v[q][j][0] + v[q][j][1] * v[q][j][1]) + (v[q][j][2] * v[q][j][2] + v[q][j][3] * v[q][j][3]);
#pragma unroll
        for (int q = 0; q < 2; ++q) { const int row = (row0 + q * NGW < MTOK) ? row0 + q * NGW : row0; const int b = row >> 12;
            const float rn = __builtin_amdgcn_rsqf(wave_sum(ss[q]) * (1.0f / DM) + EPS);
            const float* mb = mod + (size_t)b * NMOD;
            u32x2* o8 = (u32x2*)(H + (size_t)row * DM) + lane;
#pragma unroll
            for (int j = 0; j < 4; ++j) { const int c = 4 * (lane + 64 * j);
                const f32x4 gv = *(const f32x4*)(g + c), sc = *(const f32x4*)(mb + sc_off + c), sh = *(const f32x4*)(mb + sh_off + c);
                const f32x4 y = v[q][j] * rn * gv * (sc + 1.0f) + sh;
                u32x2 w; w.x = pk2(y[0], y[1]); w.y = pk2(y[2], y[3]); o8[64 * j] = w; } }
    }
}

__device__ __forceinline__ void norm_rows_bf(const bf16_t* __restrict__ X, const float* __restrict__ g, const float* __restrict__ mod, int sh_off, int sc_off, bf16_t* __restrict__ H, int G) {
    const int tid = tid_fresh(), lane = tid & 63, wid = tid >> 6;
    const int gw = blockIdx.x * 8 + wid, NGW = G * 8;
    for (int row0 = gw; row0 < MTOK; row0 += 2 * NGW) {
        u32x4 w[2][2]; float ss[2] = {0.f, 0.f};
#pragma unroll
        for (int q = 0; q < 2; ++q) { const int rq = (row0 + q * NGW < MTOK) ? row0 + q * NGW : row0; const u32x4* xr = (const u32x4*)(X + (size_t)rq * DM + 16 * lane);
            w[q][0] = xr[0]; w[q][1] = xr[1]; }
#pragma unroll
        for (int q = 0; q < 2; ++q) { const int row = (row0 + q * NGW < MTOK) ? row0 + q * NGW : row0; const int b = row >> 12;
            float v[16];
#pragma unroll
            for (int e = 0; e < 2; ++e) { v[8 * e] = bf_lo(w[q][e].x); v[8 * e + 1] = bf_hi(w[q][e].x); v[8 * e + 2] = bf_lo(w[q][e].y); v[8 * e + 3] = bf_hi(w[q][e].y);
                v[8 * e + 4] = bf_lo(w[q][e].z); v[8 * e + 5] = bf_hi(w[q][e].z); v[8 * e + 6] = bf_lo(w[q][e].w); v[8 * e + 7] = bf_hi(w[q][e].w); }
#pragma unroll
            for (int i = 0; i < 16; ++i) ss[q] += v[i] * v[i];
            const float rn = __builtin_amdgcn_rsqf(wave_sum(ss[q]) * (1.0f / DM) + EPS);
            const float* mb = mod + (size_t)b * NMOD; const int c = 16 * lane;
            unsigned o[8];
#pragma unroll
            for (int j = 0; j < 4; ++j) { const f32x4 gv = *(const f32x4*)(g + c + 4 * j), sc = *(const f32x4*)(mb + sc_off + c + 4 * j), sh = *(const f32x4*)(mb + sh_off + c + 4 * j);
                const f32x4 x = (f32x4){v[4 * j], v[4 * j + 1], v[4 * j + 2], v[4 * j + 3]};
                const f32x4 y = x * rn * gv * (sc + 1.0f) + sh; o[2 * j] = pk2(y[0], y[1]); o[2 * j + 1] = pk2(y[2], y[3]); }
            u32x4* op = (u32x4*)(H + (size_t)row * DM + c);
            op[0] = (u32x4){o[0], o[1], o[2], o[3]}; op[1] = (u32x4){o[4], o[5], o[6], o[7]}; }
    }
}

__device__ __forceinline__ void attn_unit(LAS unsigned char* lds, const bf16_t* __restrict__ DQ, const bf16_t* __restrict__ DK, const bf16_t* __restrict__ VT,
                                          bf16_t* __restrict__ OD, const float* __restrict__ g_out, float lam, int b, int h, int qb) {
    const int tid = tid_fresh(), lane = tid & 63, r = lane & 31, hh = lane >> 5;
    const int wid = __builtin_amdgcn_readfirstlane(tid >> 6), sub = wid & 3, map = wid >> 2;
    constexpr int STB = 32768, ST_V = 16384;
    const size_t tok0 = (size_t)b * SEQ;
    bf16x8 qf[4];
    { const bf16_t* qp = DQ + (tok0 + qb * 128 + sub * 32 + r) * 512 + h * 128 + map * 64 + hh * 8;
#pragma unroll
      for (int s = 0; s < 4; ++s) qf[s] = *(const bf16x8*)(qp + 16 * s); }
    asm volatile("" : "+v"(qf[0]), "+v"(qf[1]), "+v"(qf[2]), "+v"(qf[3]));
    const char* ksrc[2]; const char* vsrc[2];
#pragma unroll
    for (int i = 0; i < 2; ++i) { const int key = (4 * i + (lane >> 4)) & 7, c = (lane & 7) ^ key;
        const int krow = ((wid & 3) * 2 + i) * 8 + (lane >> 3), vrow = (wid * 2 + i) * 8 + (lane >> 3);
        ksrc[i] = (const char*)(DK + (tok0 + krow) * 512 + h * 128 + map * 64 + c * 8);
        vsrc[i] = (const char*)(VT + ((size_t)b * 1024 + 512 + h * 128 + vrow) * SEQ + c * 8); }
    const unsigned dbase = (unsigned)wid * 2048u;
#define AT_DMA(t, st) do { _Pragma("unroll") for (int i_ = 0; i_ < 2; ++i_) { \
        __builtin_amdgcn_global_load_lds((const unsigned*)(ksrc[i_] + (size_t)(t) * 65536), (LAS unsigned*)(lds + (st) * STB + dbase + i_ * 1024), 16, 0, 0); \
        __builtin_amdgcn_global_load_lds((const unsigned*)(vsrc[i_] + (size_t)(t) * 128), (LAS unsigned*)(lds + (st) * STB + ST_V + dbase + i_ * 1024), 16, 0, 0); } } while (0)
    const int NT = 2 * qb + 2, my_nt = (sub < 2) ? NT - 1 : NT;
    f32x16 o[4];
#pragma unroll
    for (int d = 0; d < 4; ++d)
#pragma unroll
        for (int i = 0; i < 16; ++i) o[d][i] = 0.f;
    float lsum = 0.f;
    int foff[4];
#pragma unroll
    for (int s = 0; s < 4; ++s) foff[s] = r * 128 + (((2 * s + hh) ^ ((r >> 1) & 7)) * 16);
    AT_DMA(0, 0); AT_DMA(1, 1);
    asm volatile("s_waitcnt vmcnt(0)" ::: "memory"); __builtin_amdgcn_s_barrier(); asm volatile("" ::: "memory");
    const int NP = qb + 1;
    float ls = 0.f;
#define AT_SB() __builtin_amdgcn_sched_barrier(0)
#define AT_KLD(KB) do { _Pragma("unroll") for (int s_ = 0; s_ < 4; ++s_) { kf[2 * s_] = *(const LAS bf16x8*)((KB) + foff[s_]); kf[2 * s_ + 1] = *(const LAS bf16x8*)((KB) + 4096 + foff[s_]); } } while (0)
#define AT_QK(S0, S1) do { _Pragma("unroll") for (int i_ = 0; i_ < 16; ++i_) { S0[i_] = 0.f; S1[i_] = 0.f; } \
        _Pragma("unroll") for (int s_ = 0; s_ < 4; ++s_) { S0 = __builtin_amdgcn_mfma_f32_32x32x16_bf16(kf[2 * s_], qf[s_], S0, 0, 0, 0); \
            S1 = __builtin_amdgcn_mfma_f32_32x32x16_bf16(kf[2 * s_ + 1], qf[s_], S1, 0, 0, 0); } } while (0)
#define AT_EXPBLK(SV, Q, OUT) do { _Pragma("unroll") for (int i_ = 0; i_ < 8; ++i_) { SV[(Q) + i_] = __builtin_amdgcn_exp2f(SV[(Q) + i_]); } \
        ls += ((SV[(Q)] + SV[(Q) + 1]) + (SV[(Q) + 2] + SV[(Q) + 3])) + ((SV[(Q) + 4] + SV[(Q) + 5]) + (SV[(Q) + 6] + SV[(Q) + 7])); \
        u32x4 w_; w_.x = pk2(SV[(Q)], SV[(Q) + 1]); w_.y = pk2(SV[(Q) + 2], SV[(Q) + 3]); w_.z = pk2(SV[(Q) + 4], SV[(Q) + 5]); w_.w = pk2(SV[(Q) + 6], SV[(Q) + 7]); \
        OUT = __builtin_bit_cast(bf16x8, w_); } while (0)
#define AT_PV(VF, PF) do { _Pragma("unroll") for (int dt_ = 0; dt_ < 4; ++dt_) o[dt_] = __builtin_amdgcn_mfma_f32_32x32x16_bf16(VF[dt_], PF, o[dt_], 0, 0, 0); } while (0)
#define AT_VLD(VF, VB, KS) do { _Pragma("unroll") for (int dt_ = 0; dt_ < 4; ++dt_) VF[dt_] = *(const LAS bf16x8*)((VB) + dt_ * 4096 + foff[KS]); } while (0)
#define AT_TILE(STG) do { const LAS unsigned char* kb_ = lds + (STG) * STB + map * 8192; const LAS unsigned char* vb_ = lds + (STG) * STB + ST_V; \
        f32x16 a0, a1; AT_KLD(kb_); AT_VLD(vfa, vb_, 0); AT_PV(vfb, pfn); AT_SB(); AT_QK(a0, a1); AT_SB(); AT_EXPBLK(a0, 0, pfc); AT_SB(); \
        AT_VLD(vfb, vb_, 1); AT_PV(vfa, pfc); AT_EXPBLK(a0, 8, pfn); AT_SB(); \
        AT_VLD(vfa, vb_, 2); AT_PV(vfb, pfn); AT_EXPBLK(a1, 0, pfc); AT_SB(); \
        AT_VLD(vfb, vb_, 3); AT_PV(vfa, pfc); AT_EXPBLK(a1, 8, pfn); AT_SB(); } while (0)
    bf16x8 kf[8], vfa[4], vfb[4], pfc, pfn;
#pragma unroll
    for (int i = 0; i < 8; ++i) { pfn[i] = 0;
#pragma unroll
        for (int dt = 0; dt < 4; ++dt) vfb[dt][i] = 0; }
    for (int j = 0; j < NP - 1; ++j) {
        const int st0 = (j & 1) * 2, sn = ((j + 1) & 1) * 2;
        const LAS unsigned char* kb0 = lds + st0 * STB + map * 8192; const LAS unsigned char* vb0 = lds + st0 * STB + ST_V;
        const LAS unsigned char* kb1 = kb0 + STB; const LAS unsigned char* vb1 = vb0 + STB;
        f32x16 a0, a1, b0, b1;
        AT_DMA(2 * j + 2, sn); AT_KLD(kb0); AT_VLD(vfa, vb0, 0); AT_PV(vfb, pfn); AT_SB();
        AT_QK(a0, a1); AT_SB();
        AT_DMA(2 * j + 3, sn + 1); AT_KLD(kb1); AT_SB();
        AT_QK(b0, b1); AT_EXPBLK(a0, 0, pfc); AT_SB();
        AT_VLD(vfb, vb0, 1); AT_PV(vfa, pfc); AT_EXPBLK(a0, 8, pfn); AT_SB();
        AT_VLD(vfa, vb0, 2); AT_PV(vfb, pfn); AT_EXPBLK(a1, 0, pfc); AT_SB();
        AT_VLD(vfb, vb0, 3); AT_PV(vfa, pfc); AT_EXPBLK(a1, 8, pfn); AT_SB();
        AT_VLD(vfa, vb1, 0); AT_PV(vfb, pfn); AT_EXPBLK(b0, 0, pfc); AT_SB();
        AT_VLD(vfb, vb1, 1); AT_PV(vfa, pfc); AT_EXPBLK(b0, 8, pfn); AT_SB();
        AT_VLD(vfa, vb1, 2); AT_PV(vfb, pfn); AT_EXPBLK(b1, 0, pfc); AT_SB();
        AT_VLD(vfb, vb1, 3); AT_PV(vfa, pfc); AT_EXPBLK(b1, 8, pfn); AT_SB();
        asm volatile("s_waitcnt vmcnt(0)" ::: "memory");
        __builtin_amdgcn_s_barrier(); asm volatile("" ::: "memory");
    }
    {
        const int st0 = ((NP - 1) & 1) * 2;
        AT_TILE(st0);
        if (sub >= 2) AT_TILE(st0 + 1);
        AT_PV(vfb, pfn);
        __builtin_amdgcn_s_barrier(); asm volatile("" ::: "memory");
    }
    lsum += ls;
#undef AT_SB
#undef AT_KLD
#undef AT_QK
#undef AT_EXPBLK
#undef AT_PV
#undef AT_VLD
#undef AT_TILE
#undef AT_DMA
    lsum += __shfl_xor(lsum, 32);
    const float rl = 1.0f / lsum;
    LAS float* xch = (LAS float*)lds;
    if (map == 1) {
#pragma unroll
        for (int dt = 0; dt < 4; ++dt)
#pragma unroll
            for (int i = 0; i < 16; ++i) xch[((sub * 4 + dt) * 16 + i) * 64 + lane] = o[dt][i] * rl;
    }
    __syncthreads();
    if (map == 0) {
        float ss = 0.f;
#pragma unroll
        for (int dt = 0; dt < 4; ++dt)
#pragma unroll
            for (int i = 0; i < 16; ++i) { const float v = o[dt][i] * rl - lam * xch[((sub * 4 + dt) * 16 + i) * 64 + lane]; o[dt][i] = v; ss += v * v; }
        ss += __shfl_xor(ss, 32);
        const float rn = __builtin_amdgcn_rsqf(ss * (1.0f / 128.0f) + EPS) * 0.8f;
        LAS unsigned char* stg = lds + 65536 + sub * (32 * 272);
#pragma unroll
        for (int dt = 0; dt < 4; ++dt)
#pragma unroll
            for (int g4 = 0; g4 < 4; ++g4) { const int dv0 = 32 * dt + 8 * g4 + 4 * hh; const f32x4 gv = *(const f32x4*)(g_out + dv0);
                u32x2 w; w.x = pk2(o[dt][4 * g4] * rn * gv[0], o[dt][4 * g4 + 1] * rn * gv[1]); w.y = pk2(o[dt][4 * g4 + 2] * rn * gv[2], o[dt][4 * g4 + 3] * rn * gv[3]);
                *(LAS u32x2*)(stg + r * 272 + dv0 * 2) = w; }
        asm volatile("s_waitcnt lgkmcnt(0)" ::: "memory");
        bf16_t* op = OD + (tok0 + qb * 128 + sub * 32) * 512 + h * 128;
#pragma unroll
        for (int i = 0; i < 8; ++i) { const int row = i * 4 + (lane >> 4), ch = lane & 15;
            const u32x4 v = *(const LAS u32x4*)(stg + row * 272 + ch * 16);
            *(u32x4*)(op + (size_t)row * 512 + ch * 8) = v; }
    }
    __syncthreads();
}

__device__ __forceinline__ void gla_item(LAS unsigned char* lds, const bf16_t* __restrict__ GQ, const bf16_t* __restrict__ GK, const float* __restrict__ LA,
                                         const bf16_t* __restrict__ VT, const bf16_t* __restrict__ GR, const float* __restrict__ g_out, bf16_t* __restrict__ OG, int b, int h) {
    constexpr int KP = 144;
    constexpr int O_QF = 0, O_QB = 9216, O_KF = 18432, O_KB = 27648, O_KDT = 36864, O_VT = 46080, O_ST = 64512, O_AL = 82944, O_SEG = 92160, O_DEC = 100352, O_SSQ = 100608, O_GR = 102400, O_OS = 119808, GP = 272;
    const int tid = tid_fresh(), lane = tid & 63, r = lane & 31, hh = lane >> 5;
    const int wid = __builtin_amdgcn_readfirstlane(tid >> 6);
    const int dp = tid & 31, sg = tid >> 5;
    const int dkt = wid >> 2, dvt = wid & 3, lt = wid >> 2;
    LAS f32x2* segtot = (LAS f32x2*)(lds + O_SEG); LAS float* dec = (LAS float*)(lds + O_DEC); LAS float* ssq = (LAS float*)(lds + O_SSQ);
    f32x16 S;
#pragma unroll
    for (int i = 0; i < 16; ++i) S[i] = 0.f;
    const size_t rbase = (size_t)b * SEQ * 256 + (size_t)(4 * sg) * 256 + h * 64 + 2 * dp;
    const bf16_t* vbase0 = VT + ((size_t)b * 1024 + h * 128 + (tid >> 3)) * SEQ + (tid & 7) * 8;
    f32x2 cum[4], la_n[4]; unsigned q_n[4], k_n[4]; u32x4 v_n[2], g_n[2];
    const int goff = (tid >> 4) * 512 + (tid & 15) * 8;
    const bf16_t* gbase0 = GR + (size_t)b * SEQ * 512 + h * 128;
    bf16_t* obase0 = OG + (size_t)b * SEQ * 512 + h * 128;
#pragma unroll
    for (int i = 0; i < 4; ++i) { cum[i] = *(const f32x2*)(LA + rbase + i * 256); la_n[i] = *(const f32x2*)(LA + rbase + 64 * 256 + i * 256);
        q_n[i] = *(const unsigned*)(GQ + rbase + i * 256); k_n[i] = *(const unsigned*)(GK + rbase + i * 256); }
#pragma unroll
    for (int j = 0; j < 2; ++j) { v_n[j] = *(const u32x4*)(vbase0 + (size_t)j * 64 * SEQ); g_n[j] = *(const u32x4*)(gbase0 + goff + j * 32 * 512); }
#pragma unroll
    for (int i = 1; i < 4; ++i) cum[i] += cum[i - 1];
    segtot[sg * 32 + dp] = cum[3];
    __syncthreads();
    for (int n = 0; n < SEQ / 64; ++n) {
        const size_t t0 = (size_t)b * SEQ + 64 * n;
        LAS f32x2* segc = segtot + (n & 1) * 512; LAS f32x2* segn = segtot + ((n + 1) & 1) * 512;
        {
            f32x2 prefix = {0.f, 0.f}, total = {0.f, 0.f};
#pragma unroll 4
            for (int s = 0; s < 16; ++s) { const f32x2 v = segc[s * 32 + dp]; total += v; if (s < sg) prefix += v; }
            f32x2 etot; etot.x = __expf(total.x); etot.y = __expf(total.y);
            float kd0[4], kd1[4];
#pragma unroll
            for (int i = 0; i < 4; ++i) { const f32x2 cm = prefix + cum[i]; f32x2 ep, em; ep.x = __expf(cm.x); ep.y = __expf(cm.y);
                em.x = __builtin_amdgcn_rcpf(ep.x); em.y = __builtin_amdgcn_rcpf(ep.y);
                const float q0 = bf_lo(q_n[i]), q1 = bf_hi(q_n[i]), k0 = bf_lo(k_n[i]), k1 = bf_hi(k_n[i]);
                const int o = (4 * sg + i) * KP + dp * 4;
                *(LAS unsigned*)(lds + O_QF + o) = pk2(q0 * ep.x, q1 * ep.y);
                *(LAS unsigned*)(lds + O_QB + o) = pk2(q0 * em.x, q1 * em.y);
                *(LAS unsigned*)(lds + O_KF + o) = pk2(k0 * em.x, k1 * em.y);
                *(LAS unsigned*)(lds + O_KB + o) = pk2(k0 * ep.x, k1 * ep.y);
                kd0[i] = k0 * (etot.x * em.x); kd1[i] = k1 * (etot.y * em.y); }
            u32x2 w0, w1; w0.x = pk2(kd0[0], kd0[1]); w0.y = pk2(kd0[2], kd0[3]); w1.x = pk2(kd1[0], kd1[1]); w1.y = pk2(kd1[2], kd1[3]);
            *(LAS u32x2*)(lds + O_KDT + (2 * dp) * KP + sg * 8) = w0;
            *(LAS u32x2*)(lds + O_KDT + (2 * dp + 1) * KP + sg * 8) = w1;
            if (sg == 0) { dec[2 * dp] = etot.x; dec[2 * dp + 1] = etot.y; }
#pragma unroll
            for (int j = 0; j < 2; ++j) { const int c = tid + 512 * j; const int ch = c & 7; LAS unsigned char* vp = lds + O_VT + (c >> 3) * KP + ((ch >> 1) * 16 + (ch & 1) * 4) * 2;
                u32x2 lo, hi; lo.x = v_n[j].x; lo.y = v_n[j].y; hi.x = v_n[j].z; hi.y = v_n[j].w; *(LAS u32x2*)vp = lo; *(LAS u32x2*)(vp + 16) = hi; }
            { const int n1 = (n + 1 < SEQ / 64) ? n + 1 : n;
#pragma unroll
              for (int i = 0; i < 4; ++i) { const size_t o1 = rbase + (size_t)n1 * 64 * 256 + i * 256; q_n[i] = __builtin_nontemporal_load((const unsigned*)(GQ + o1)); k_n[i] = __builtin_nontemporal_load((const unsigned*)(GK + o1)); }
#pragma unroll
              for (int j = 0; j < 2; ++j) v_n[j] = __builtin_nontemporal_load((const u32x4*)(vbase0 + (size_t)j * 64 * SEQ + 64 * n1)); }
        }
        __syncthreads();
        if (wid < 4) {
            const int ltile = (wid == 1 || wid == 2) ? 1 : 0, mtile = (wid == 1 || wid == 3) ? 1 : 0;
            const bool needf = (wid != 3), needb = (wid != 2);
            f32x16 af, ab;
#pragma unroll
            for (int i = 0; i < 16; ++i) { af[i] = 0.f; ab[i] = 0.f; }
            const int ko = (32 * mtile + r) * KP + hh * 16, qo = (32 * ltile + r) * KP + hh * 16;
            if (needf) {
#pragma unroll
                for (int s = 0; s < 4; ++s) af = __builtin_amdgcn_mfma_f32_32x32x16_bf16(*(const LAS bf16x8*)(lds + O_KF + ko + s * 32), *(const LAS bf16x8*)(lds + O_QF + qo + s * 32), af, 0, 0, 0);
            }
            if (needb) {
#pragma unroll
                for (int s = 0; s < 4; ++s) ab = __builtin_amdgcn_mfma_f32_32x32x16_bf16(*(const LAS bf16x8*)(lds + O_KB + ko + s * 32), *(const LAS bf16x8*)(lds + O_QB + qo + s * 32), ab, 0, 0, 0);
            }
            const int lg = 32 * ltile + r;
#pragma unroll
            for (int g4 = 0; g4 < 4; ++g4) { float v[4];
#pragma unroll
                for (int j = 0; j < 4; ++j) { const int mg = 32 * mtile + 8 * g4 + 4 * hh + j; v[j] = (lg >= mg) ? af[4 * g4 + j] : ab[4 * g4 + j]; }
                u32x2 w; w.x = pk2(v[0], v[1]); w.y = pk2(v[2], v[3]);
                *(LAS u32x2*)(lds + O_AL + lg * KP + (32 * mtile + 8 * g4 + 4 * hh) * 2) = w; }
        }
#pragma unroll
        for (int g4 = 0; g4 < 4; ++g4) { u32x2 w; w.x = pk2(S[4 * g4], S[4 * g4 + 1]); w.y = pk2(S[4 * g4 + 2], S[4 * g4 + 3]);
            *(LAS u32x2*)(lds + O_ST + (32 * dvt + r) * KP + (32 * dkt + 8 * g4 + 4 * hh) * 2) = w; }
#pragma unroll
        for (int j = 0; j < 2; ++j) { const int c = tid + 512 * j; *(LAS u32x4*)(lds + O_GR + (c >> 4) * GP + (c & 15) * 16) = g_n[j]; }
        { const int n1 = (n + 1 < SEQ / 64) ? n + 1 : n;
#pragma unroll
          for (int j = 0; j < 2; ++j) g_n[j] = __builtin_nontemporal_load((const u32x4*)(gbase0 + (size_t)n1 * 64 * 512 + goff + j * 32 * 512)); }
        if (n > 0) {
#pragma unroll
            for (int j = 0; j < 2; ++j) { const int c = tid + 512 * j; const u32x4 v = *(const LAS u32x4*)(lds + O_OS + (c >> 4) * GP + (c & 15) * 16);
                *(u32x4*)(obase0 + (size_t)(n - 1) * 64 * 512 + goff + j * 32 * 512) = v; }
        }
#pragma unroll
        for (int i = 0; i < 4; ++i) cum[i] = la_n[i];
#pragma unroll
        for (int i = 1; i < 4; ++i) cum[i] += cum[i - 1];
        segn[sg * 32 + dp] = cum[3];
        { const int n2 = (n + 2 < SEQ / 64) ? n + 2 : SEQ / 64 - 1;
#pragma unroll
          for (int i = 0; i < 4; ++i) la_n[i] = __builtin_nontemporal_load((const f32x2*)(LA + rbase + (size_t)n2 * 64 * 256 + i * 256)); }
        __syncthreads();
        f32x16 o;
#pragma unroll
        for (int i = 0; i < 16; ++i) o[i] = 0.f;
        {
            const int vo = (32 * dvt + r) * KP + hh * 16, lo = (32 * lt + r) * KP + hh * 16;
#pragma unroll
            for (int s = 0; s < 4; ++s) o = __builtin_amdgcn_mfma_f32_32x32x16_bf16(*(const LAS bf16x8*)(lds + O_VT + vo + s * 32), *(const LAS bf16x8*)(lds + O_AL + lo + s * 32), o, 0, 0, 0);
#pragma unroll
            for (int s = 0; s < 4; ++s) o = __builtin_amdgcn_mfma_f32_32x32x16_bf16(*(const LAS bf16x8*)(lds + O_ST + vo + s * 32), *(const LAS bf16x8*)(lds + O_QF + lo + s * 32), o, 0, 0, 0);
#pragma unroll
            for (int g4 = 0; g4 < 4; ++g4) { const f32x4 dc = *(const LAS f32x4*)(dec + 32 * dkt + 8 * g4 + 4 * hh);
#pragma unroll
                for (int j = 0; j < 4; ++j) S[4 * g4 + j] *= dc[j]; }
            const int ka = (32 * dkt + r) * KP + hh * 16;
#pragma unroll
            for (int s = 0; s < 4; ++s) S = __builtin_amdgcn_mfma_f32_32x32x16_bf16(*(const LAS bf16x8*)(lds + O_KDT + ka + s * 32), *(const LAS bf16x8*)(lds + O_VT + vo + s * 32), S, 0, 0, 0);
        }
        float ss = 0.f;
#pragma unroll
        for (int i = 0; i < 16; ++i) ss += o[i] * o[i];
        ss += __shfl_xor(ss, 32);
        if (hh == 0) ssq[(lt * 4 + dvt) * 32 + r] = ss;
        __syncthreads();
        {
            const float tot = (ssq[(lt * 4 + 0) * 32 + r] + ssq[(lt * 4 + 1) * 32 + r]) + (ssq[(lt * 4 + 2) * 32 + r] + ssq[(lt * 4 + 3) * 32 + r]);
            const float rn = __builtin_amdgcn_rsqf(tot * (1.0f / 128.0f) + EPS);
#pragma unroll
            for (int g4 = 0; g4 < 4; ++g4) { const int dv0 = 32 * dvt + 8 * g4 + 4 * hh; const int lo_ = (32 * lt + r) * GP + dv0 * 2;
                const u32x2 gt = *(const LAS u32x2*)(lds + O_GR + lo_); const f32x4 gv = *(const f32x4*)(g_out + dv0);
                u32x2 w; w.x = pk2(o[4 * g4] * rn * gv[0] * bf_lo(gt.x), o[4 * g4 + 1] * rn * gv[1] * bf_hi(gt.x));
                w.y = pk2(o[4 * g4 + 2] * rn * gv[2] * bf_lo(gt.y), o[4 * g4 + 3] * rn * gv[3] * bf_hi(gt.y));
                *(LAS u32x2*)(lds + O_OS + lo_) = w; }
        }
    }
    __syncthreads();
#pragma unroll
    for (int j = 0; j < 2; ++j) { const int c = tid + 512 * j; const u32x4 v = *(const LAS u32x4*)(lds + O_OS + (c >> 4) * GP + (c & 15) * 16);
        *(u32x4*)(obase0 + (size_t)(SEQ / 64 - 1) * 64 * 512 + goff + j * 32 * 512) = v; }
    __syncthreads();
}

#define XB_TMO      128
#define XB_XCNT(j)  (256  + 64 * (j))
#define XB_XSUB(j)  (1280 + 64 * (j))
#define XB_XGEN(j)  (2304 + 64 * (j))
#define XB_TOP      3328
#define XB_TOPGEN   3392
#define XCD_BAR_WORDS 3456
#define XB_SPIN_CAP (1u << 18)

__device__ __forceinline__ unsigned xb_ld(unsigned* p)              { return __hip_atomic_load(p, __ATOMIC_RELAXED, __HIP_MEMORY_SCOPE_AGENT); }
__device__ __forceinline__ unsigned xb_add(unsigned* p, unsigned v) { return __hip_atomic_fetch_add(p, v, __ATOMIC_RELAXED, __HIP_MEMORY_SCOPE_AGENT); }
__device__ __forceinline__ unsigned xb_xcc_id() { return (unsigned)__builtin_amdgcn_s_getreg((3 << 11) | 20) & 0xFu; }
#define XB_SPIN(cond, bar) do { unsigned _sp = 0; while (cond) { __builtin_amdgcn_s_sleep(1); \
    if ((++_sp & 255u) == 0u) { if (xb_ld(&(bar)[XB_TMO])) break; if (_sp > XB_SPIN_CAP) { atomicAdd(&(bar)[XB_TMO], 1u); break; } } } } while (0)

struct XcdBarrier {
    unsigned* bar; unsigned x;
    volatile LAS unsigned* st;
};

__device__ __forceinline__ XcdBarrier xcd_barrier_post(unsigned* bar, volatile LAS unsigned* st) {
    XcdBarrier b; b.bar = bar; b.x = xb_xcc_id(); b.st = st;
    if (threadIdx.x == 0) (void)xb_add(&bar[XB_XCNT(b.x)], 1u);
    return b;
}
__device__ __forceinline__ void xcd_barrier_complete(unsigned* bar, unsigned x, unsigned& nloc, unsigned& nx) {
    const unsigned G = gridDim.x * gridDim.y * gridDim.z;
    unsigned sum, cnt, mine, sp = 0u;
    for (;;) {
        sum = 0u; cnt = 0u; mine = 0u;
#pragma unroll
        for (unsigned j = 0; j < 16; ++j) { const unsigned c = xb_ld(&bar[XB_XCNT(j)]); sum += c; cnt += (c > 0u) ? 1u : 0u; mine = (j == x) ? c : mine; }
        if (sum == G) break;
        __builtin_amdgcn_s_sleep(1);
        if ((++sp & 255u) == 0u) { if (xb_ld(&bar[XB_TMO])) break; if (sp > XB_SPIN_CAP) { atomicAdd(&bar[XB_TMO], 1u); break; } }
    }
    nloc = mine > 0u ? mine : 1u; nx = cnt > 0u ? cnt : 1u;
}

__device__ __forceinline__ void xcd_barrier(const XcdBarrier& b) {
    asm volatile("s_waitcnt vmcnt(0)" ::: "memory");
    __syncthreads();
    if (threadIdx.x == 0) {
        unsigned* bar = b.bar;
        __builtin_amdgcn_s_waitcnt(0);
        unsigned nloc = b.st[0], nx = b.st[1];
        if (nloc == 0u) { xcd_barrier_complete(bar, b.x, nloc, nx); b.st[0] = nloc; b.st[1] = nx; }
        const unsigned old = xb_add(&bar[XB_XSUB(b.x)], 1u);
        const unsigned gen = old / nloc;
        if (old + 1u == (gen + 1u) * nloc) {
            __builtin_amdgcn_fence(__ATOMIC_RELEASE, "agent");
            asm volatile("s_waitcnt vmcnt(0)" ::: "memory");
            const unsigned og = xb_add(&bar[XB_TOP], 1u);
            const unsigned tg = og / nx;
            if (og + 1u == (tg + 1u) * nx) xb_add(&bar[XB_TOPGEN], 1u);
            else XB_SPIN(xb_ld(&bar[XB_TOPGEN]) == tg, bar);
            __builtin_amdgcn_fence(__ATOMIC_ACQUIRE, "agent");
            xb_add(&bar[XB_XGEN(b.x)], 1u);
            asm volatile("s_waitcnt vmcnt(0)" ::: "memory");
        } else {
            XB_SPIN(xb_ld(&bar[XB_XGEN(b.x)]) == gen, bar);
            __builtin_amdgcn_fence(__ATOMIC_ACQUIRE, "agent");
            asm volatile("s_waitcnt vmcnt(0)" ::: "memory");
        }
    }
    __syncthreads();
}


constexpr int NPHASE = 9;
#ifndef PROBE_MODE
#define PROBE_MODE 0
#endif
__global__ void __launch_bounds__(512, 2) fwd_kernel(Args args) {
    extern __shared__ __attribute__((aligned(16))) unsigned char lds_raw[];
    LAS unsigned char* lds = (LAS unsigned char*)lds_raw;
    cg::grid_group grid = cg::this_grid();
    const int G = gridDim.x; const int lo = args.ph_lo, hi = args.ph_hi;
    unsigned char* ws = args.ws;
    const float* x = args.in[0];
    float* mod = (float*)(ws + WS_MOD);
    bf16_t* H = (bf16_t*)(ws + WS_H);
#define IN(k) (lo <= (k) && (k) < hi)
    { volatile LAS unsigned* st0 = (volatile LAS unsigned*)(lds + 140016); if (threadIdx.x < 2) st0[threadIdx.x] = 0u; }
    __syncthreads();
    XcdBarrier xbar = xcd_barrier_post((unsigned*)(ws + WS_BAR), (volatile LAS unsigned*)(lds + 140016));
    if (lo < 0) grid.sync();
#define SEAM(k) do { if (IN(k) && IN((k) + 1)) xcd_barrier(xbar); } while (0)
    if (IN(0)) phase0(args, lds, G);
    SEAM(0);
    if (IN(1)) norm_rows(x, args.in[4], mod, 0, DM, H, G);
    SEAM(1);
    if (IN(2)) {
        { pg8::Gemm g{H, H, (const bf16_t*)(ws + WS_WA), (const bf16_t*)(ws + WS_WA), MTOK, NA, DM};
          typedef pg8::StaticOrder<MTOK / 256, NA / 256, 0> SO; SO S; S.init(G, (int)blockIdx.x);
          pg8::EpiInA E{(bf16_t*)(ws + WS_GQ), (bf16_t*)(ws + WS_GK), (bf16_t*)(ws + WS_GR), (bf16_t*)(ws + WS_DQ), (bf16_t*)(ws + WS_DK), (bf16_t*)(ws + WS_G1), (bf16_t*)(ws + WS_G2),
                        (float*)(ws + WS_LA), args.in[7], args.in[9], args.in[10]};
          pg8::gemm_phase<pg8::EpiInA, SO, true, true>(lds, g, S, E); }
        { pg8::Gemm g{(const bf16_t*)(ws + WS_WV), (const bf16_t*)(ws + WS_WV), H, H, 1024, MTOK, DM};
          typedef pg8::StaticOrder<4, MTOK / 256, 0> SO; SO S; S.init(G, (int)blockIdx.x);
          pg8::EpiInV E{(bf16_t*)(ws + WS_VT)};
          pg8::gemm_phase<pg8::EpiInV, SO, true, true>(lds, g, S, E); }
    }
    SEAM(2);
    if (IN(3)) {
        unsigned* qctr = (unsigned*)(ws + WS_MISC) + 8;
        const float lam = ((const float*)(ws + WS_MISC))[1];
        LAS unsigned* slot = (LAS unsigned*)(lds + 140000);
        for (int kq = 0; kq < 8; ++kq) {
            const int xl = ((int)blockIdx.x + kq) & 7;
            for (;;) {
                if (threadIdx.x == 0) *slot = __hip_atomic_fetch_add(qctr + xl, 1u, __ATOMIC_RELAXED, __HIP_MEMORY_SCOPE_AGENT);
                __syncthreads();
                const unsigned item = *slot;
                __syncthreads();
                if (item >= 8u + 256u) break;
                if (item < 8u) { const int bh = xl * 8 + (int)item;
                    gla_item(lds, (const bf16_t*)(ws + WS_GQ), (const bf16_t*)(ws + WS_GK), (const float*)(ws + WS_LA), (const bf16_t*)(ws + WS_VT), (const bf16_t*)(ws + WS_GR),
                             args.in[8], (bf16_t*)(ws + WS_OG), bh >> 2, bh & 3); }
                else { const unsigned a = item - 8u; const int bh = xl * 8 + (int)(a >> 5), qb = 31 - (int)(a & 31);
                    attn_unit(lds, (const bf16_t*)(ws + WS_DQ), (const bf16_t*)(ws + WS_DK), (const bf16_t*)(ws + WS_VT), (bf16_t*)(ws + WS_OD), args.in[15], lam, bh >> 2, bh & 3, qb); }
            }
        }
    }
#if PROBE_MODE == 1
    grid.sync();
    {
        unsigned* qctr = (unsigned*)(ws + WS_MISC) + 2;
        const float lam = ((const float*)(ws + WS_MISC))[1];
        LAS unsigned* slot = (LAS unsigned*)(lds + 140000);
        for (;;) {
            if (threadIdx.x == 0) *slot = __hip_atomic_fetch_add(qctr, 1u, __ATOMIC_RELAXED, __HIP_MEMORY_SCOPE_AGENT);
            __syncthreads();
            const unsigned item = *slot;
            __syncthreads();
            if (item >= 64u + 2048u) break;
            if (item < 64u) gla_item(lds, (const bf16_t*)(ws + WS_GQ), (const bf16_t*)(ws + WS_GK), (const float*)(ws + WS_LA), (const bf16_t*)(ws + WS_VT), (const bf16_t*)(ws + WS_GR),
                                     args.in[8], (bf16_t*)(ws + WS_OG), (int)(item >> 2), (int)(item & 3));
            else { const unsigned a = item - 64u; const int qb = 31 - (int)(a >> 6), bh = (int)(a & 63);
                attn_unit(lds, (const bf16_t*)(ws + WS_DQ), (const bf16_t*)(ws + WS_DK), (const bf16_t*)(ws + WS_VT), (bf16_t*)(ws + WS_OD), args.in[15], lam, bh >> 2, bh & 3, qb); }
        }
    }
#elif PROBE_MODE == 2
    grid.sync();
    if (blockIdx.x < 64) gla_item(lds, (const bf16_t*)(ws + WS_GQ), (const bf16_t*)(ws + WS_GK), (const float*)(ws + WS_LA), (const bf16_t*)(ws + WS_VT), (const bf16_t*)(ws + WS_GR),
                                     args.in[8], (bf16_t*)(ws + WS_OG), (int)(blockIdx.x >> 2), (int)(blockIdx.x & 3));
#endif
    SEAM(3);
    if (IN(4)) {
        pg8::Gemm g{(const bf16_t*)(ws + WS_OG), (const bf16_t*)(ws + WS_OD), (const bf16_t*)(ws + WS_WBG), (const bf16_t*)(ws + WS_WBD), MTOK, DM, 512};
        typedef pg8::StaticOrder<MTOK / 256, DM / 256, 1> SO; SO S; S.init(G, (int)blockIdx.x);
        pg8::EpiMerge E{(const bf16_t*)(ws + WS_G1), (const bf16_t*)(ws + WS_G2), (bf16_t*)(ws + WS_MIX)};
        pg8::gemm_phase<pg8::EpiMerge, SO, true, true>(lds, g, S, E);
    }
    SEAM(4);
    if (IN(5)) {
        pg8::Gemm g{(const bf16_t*)(ws + WS_MIX), (const bf16_t*)(ws + WS_MIX), (const bf16_t*)(ws + WS_WO), (const bf16_t*)(ws + WS_WO), MTOK, DM, DM};
        typedef pg8::StaticOrder<MTOK / 256, DM / 256, 0> SO; SO S; S.init(G, (int)blockIdx.x);
        typedef pg8::EpiResid<false, true> EP; EP E{x, (void*)(ws + WS_X1B), mod + 2 * DM};
        pg8::gemm_phase<EP, SO, true, true>(lds, g, S, E);
    }
    SEAM(5);
    if (IN(6)) norm_rows_bf((const bf16_t*)(ws + WS_X1B), args.in[19], mod, 3 * DM, 4 * DM, H, G);
    SEAM(6);
    if (IN(7)) {
        pg8::Gemm g{H, H, (const bf16_t*)(ws + WS_WF1), (const bf16_t*)(ws + WS_WF1), MTOK, 2 * FFH, DM};
        typedef pg8::StaticOrder<MTOK / 256, 2 * FFH / 256, 0> SO; SO S; S.init(G, (int)blockIdx.x);
        pg8::EpiSwiglu E{(bf16_t*)(ws + WS_ACT)};
        pg8::gemm_phase<pg8::EpiSwiglu, SO, true, true>(lds, g, S, E);
    }
    SEAM(7);
    if (IN(8)) {
        pg8::Gemm g{(const bf16_t*)(ws + WS_ACT), (const bf16_t*)(ws + WS_ACT), (const bf16_t*)(ws + WS_WF2), (const bf16_t*)(ws + WS_WF2), MTOK, DM, FFH};
        typedef pg8::StaticOrder<MTOK / 256, DM / 256, 0> SO; SO S; S.init(G, (int)blockIdx.x);
        typedef pg8::EpiResid<true, false> EP; EP E{(const void*)(ws + WS_X1B), (void*)args.out, mod + 5 * DM};
        pg8::gemm_phase<EP, SO, true, true>(lds, g, S, E);
    }
#undef IN
#undef SEAM
}

#ifndef MK_MULTI
#define MK_MULTI 0
#endif

extern "C" void kernel_launch(void* const* d_in, const int* in_sizes, int n_in, void* d_out, int out_size, void* d_ws, size_t ws_size, hipStream_t stream) {
    static int grid = 0;
    if (grid == 0) {
        if (n_in != 22 || out_size != MTOK * DM || ws_size < WS_END) { fprintf(stderr, "kernel_launch: unexpected shapes (n_in %d out %d ws %zu)\n", n_in, out_size, ws_size); grid = -1; return; }
        int dev = 0, cus = 0, per_cu = 0;
        (void)hipGetDevice(&dev);
        (void)hipDeviceGetAttribute(&cus, hipDeviceAttributeMultiprocessorCount, dev);
        if (hipFuncSetAttribute((const void*)fwd_kernel, hipFuncAttributeMaxDynamicSharedMemorySize, LDS_BYTES) != hipSuccess) { fprintf(stderr, "kernel_launch: hipFuncSetAttribute failed\n"); grid = -1; return; }
        if (hipOccupancyMaxActiveBlocksPerMultiprocessor(&per_cu, (const void*)fwd_kernel, 512, LDS_BYTES) != hipSuccess || per_cu < 1) { fprintf(stderr, "kernel_launch: occupancy query says %d\n", per_cu); per_cu = 1; }
        (void)hipGetLastError();
        grid = cus * 1;
        fprintf(stderr, "kernel_launch: grid %d (cus %d per_cu %d)\n", grid, cus, per_cu);
    }
    if (grid < 0) return;
    Args a{};
    for (int i = 0; i < 22; ++i) a.in[i] = (const float*)d_in[i];
    a.out = (float*)d_out; a.ws = (unsigned char*)d_ws;
#if MK_MULTI
    for (int p = 0; p < NPHASE; ++p) { a.ph_lo = p; a.ph_hi = p + 1; hipLaunchKernelGGL(fwd_kernel, dim3(grid), dim3(512), LDS_BYTES, stream, a); }
#else
    a.ph_lo = 0; a.ph_hi = NPHASE;
    (void)hipMemsetAsync((unsigned char*)d_ws + WS_BAR, 0, 16384, stream);
    void* kargs[] = {&a};
    hipError_t e = hipLaunchCooperativeKernel((const void*)fwd_kernel, dim3(grid), dim3(512), kargs, LDS_BYTES, stream);
    if (e != hipSuccess) fprintf(stderr, "kernel_launch: cooperative launch failed: %s (grid %d)\n", hipGetErrorString(e), grid);
#endif
}
```

```cpp
#include <hip/hip_runtime.h>
#include <hip/hip_cooperative_groups.h>
#include <cstdio>
#include <cstdint>
namespace cg = cooperative_groups;

#define LAS __attribute__((address_space(3)))
typedef unsigned short bf16_t;
typedef short bf16x8 __attribute__((ext_vector_type(8)));
typedef float f32x4 __attribute__((ext_vector_type(4)));
typedef float f32x16 __attribute__((ext_vector_type(16)));
typedef float f32x2 __attribute__((ext_vector_type(2)));
typedef unsigned u32x4 __attribute__((ext_vector_type(4)));
typedef unsigned u32x2 __attribute__((ext_vector_type(2)));
typedef __bf16 bf16x2_t __attribute__((ext_vector_type(2)));

__device__ __forceinline__ unsigned pk2(float lo, float hi) { f32x2 v = {lo, hi}; bf16x2_t b = __builtin_convertvector(v, bf16x2_t); return __builtin_bit_cast(unsigned, b); }
__device__ __forceinline__ float bf_lo(unsigned u) { return __uint_as_float(u << 16); }
__device__ __forceinline__ float bf_hi(unsigned u) { return __uint_as_float(u & 0xffff0000u); }
__device__ __forceinline__ float bf1(bf16_t u) { return __uint_as_float(((unsigned)u) << 16); }
__device__ __forceinline__ float sigmoidf_(float x) { return __builtin_amdgcn_rcpf(1.0f + __builtin_amdgcn_exp2f(x * -1.4426950408889634f)); }
__device__ __forceinline__ float siluf_(float x) { return x * __builtin_amdgcn_rcpf(1.0f + __builtin_amdgcn_exp2f(x * -1.4426950408889634f)); }
__device__ __forceinline__ int tid_fresh() { int t = threadIdx.x; asm volatile("" : "+v"(t)); return t; }
__device__ __forceinline__ int crow(int r, int hi) { return (r & 3) + 8 * (r >> 2) + 4 * hi; }
__device__ __forceinline__ float wave_sum(float v) {
#pragma unroll
    for (int o = 1; o < 64; o <<= 1) v += __shfl_xor(v, o);
    return v;
}

constexpr int BATCH = 16, SEQ = 4096, DM = 1024, MTOK = BATCH * SEQ;
constexpr int NMOD = 6 * DM;
constexpr int INCOLS = 5136;
constexpr int NA = 4352;
constexpr int FFH = 2816;
constexpr float EPS = 1e-6f;
constexpr float LOG2E = 1.4426950408889634f;
constexpr int C_GQ = 0, C_GK = 256, C_GV = 512, C_GR = 1024, C_GA = 1536, C_DQ = 1552, C_DK = 2064, C_DV = 2576, C_G1 = 3088, C_G2 = 4112;

constexpr size_t MiB = 1u << 20;
constexpr size_t WS_MOD = 0;
constexpr size_t WS_MISC = 512 * 1024;
constexpr size_t WS_BAR = 768 * 1024;
constexpr size_t WS_WA = 1 * MiB;
constexpr size_t WS_WV = 10 * MiB;
constexpr size_t WS_WBG = 12 * MiB;
constexpr size_t WS_WBD = 13 * MiB;
constexpr size_t WS_WO = 14 * MiB;
constexpr size_t WS_WF1 = 16 * MiB;
constexpr size_t WS_WF2 = 27 * MiB;
constexpr size_t WS_H = 40 * MiB;
constexpr size_t WS_GQ = 168 * MiB;
constexpr size_t WS_GK = 200 * MiB;
constexpr size_t WS_LA = 232 * MiB;
constexpr size_t WS_GR = 296 * MiB;
constexpr size_t WS_DQ = 360 * MiB;
constexpr size_t WS_DK = 424 * MiB;
constexpr size_t WS_G1 = 488 * MiB;
constexpr size_t WS_G2 = 616 * MiB;
constexpr size_t WS_VT = 744 * MiB;
constexpr size_t WS_OG = 872 * MiB;
constexpr size_t WS_OD = 936 * MiB;
constexpr size_t WS_X1B = 872 * MiB;
constexpr size_t WS_MIX = 168 * MiB;
constexpr size_t WS_ACT = 296 * MiB;
constexpr size_t WS_END = 1000 * MiB;

constexpr int LDS_BYTES = 147456;

namespace pg8 {
constexpr int BM = 256, BK = 64, HALF = 128, HTB = HALF * BK * 2, STAGE_BYTES = 8 * HTB, NXCD = 8, WGM = 8;
__host__ __device__ __forceinline__ int lds_byte(int r, int c) { const int st = (r >> 4) * 2 + (c >> 5), rr = r & 15, cc = c & 31, ob = rr * 64 + cc * 2; return st * 1024 + (ob ^ (((ob >> 9) & 1) << 5)); }
__host__ __device__ __forceinline__ void stage_rc(int b, int& R, int& C) { const int st = b / 1024, sb = b % 1024, swz = sb ^ (((sb >> 9) & 1) << 5); R = (st >> 1) * 16 + swz / 64; C = (st & 1) * 32 + (swz % 64) / 2; }
__host__ __device__ __forceinline__ int perm32(int rho) { const int n = rho >> 4, i = rho & 15; return 8 * (i >> 2) + 4 * n + (i & 3); }
__host__ __device__ __forceinline__ int permV(int rho) { const int n = rho >> 4, fq = (rho >> 2) & 3, j = rho & 3; return 16 * (fq >> 1) + 8 * n + 4 * (fq & 1) + j; }

struct Unit { int pm, pn, seg; };
struct Gemm { const bf16_t* A0; const bf16_t* A1; const bf16_t* B0; const bf16_t* B1; int M, N, K; };

template <int NM, int NN, int DUALV>
struct StaticOrder {
    int G, c;
    __device__ void init(int G_, int c_) { G = G_; c = c_; }
    __device__ bool next(int i, Unit& u) const {
        constexpr int nwg = NM * NN, q = nwg / NXCD, r = nwg % NXCD, nig = WGM * NN;
        const int it = DUALV ? (i >> 1) : i;
        const long L = (long)it * G + c; if (L >= nwg) return false;
        int wgid = (int)L; { const int xcd = wgid % NXCD, off = wgid / NXCD; wgid = (xcd < r ? xcd * (q + 1) : r * (q + 1) + (xcd - r) * q) + off; }
        const int gid = wgid / nig, fm = gid * WGM, rem = wgid % nig;
        if constexpr (NM % WGM == 0) { u.pm = fm + (rem % WGM); u.pn = rem / WGM; }
        else { const int gsz = (NM - fm) < WGM ? (NM - fm) : WGM; u.pm = fm + (rem % gsz); u.pn = rem / gsz; }
        u.seg = DUALV ? (i & 1) : 0; return true;
    }
};

template <class Epi, class Sched, bool ALIGN_EPI, bool SP2>
__device__ __forceinline__ void gemm_phase(LAS unsigned char* lds, const Gemm g, const Sched& S, const Epi& E) {
    const int tid = tid_fresh(), wid = __builtin_amdgcn_readfirstlane(tid >> 6), lane = tid & 63, wr = wid >> 2, wc = wid & 3, fr = lane & 15, fq = lane >> 4;
    const int K = g.K, nt = K / BK;
    unsigned voffA[2], voffB[2];
#pragma unroll
    for (int i = 0; i < 2; ++i) { int R, C; stage_rc(tid * 16 + i * 8192, R, C); const int Rb = (Epi::PERM == 2) ? ((R & ~31) + permV(R & 31)) : (Epi::PERM == 1) ? ((R & ~31) + perm32(R & 31)) : R;
        voffA[i] = (unsigned)(R * K + C) * 2u; voffB[i] = (unsigned)(Rb * K + C) * 2u; }
    const size_t kstep = (size_t)(BK * 2);
    const size_t hstep = (size_t)HALF * K * 2;
    const size_t tstep = 2 * hstep;
    const unsigned ldsw = (unsigned)wid * 1024u;
    const int aoff = lds_byte(wr * 64 + fr, fq * 8), boff = lds_byte(wc * 32 + fr, fq * 8);
#define PG8_SA(b, h) (((b) * 2 + (h)) * HTB)
#define PG8_SB(b, h) ((4 + (b) * 2 + (h)) * HTB)
#define PG8_STAGE(bufoff, gbase, voff) do { _Pragma("unroll") for (int _i = 0; _i < 2; ++_i) \
        __builtin_amdgcn_global_load_lds((const unsigned*)((const char*)(gbase) + (voff)[_i]), (LAS unsigned*)(lds + (bufoff) + ldsw + _i * 8192), 16, 0, 0); } while (0)
#define PG8_LDA(dst, b, h) do { _Pragma("unroll") for (int m = 0; m < 4; ++m) _Pragma("unroll") for (int k = 0; k < 2; ++k) dst[m][k] = *(const LAS bf16x8*)(lds + PG8_SA(b, h) + aoff + m * 2048 + k * 1024); } while (0)
#define PG8_LDB(dst, b, h) do { _Pragma("unroll") for (int n = 0; n < 2; ++n) _Pragma("unroll") for (int k = 0; k < 2; ++k) dst[n][k] = *(const LAS bf16x8*)(lds + PG8_SB(b, h) + boff + n * 2048 + k * 1024); } while (0)
#define PG8_MMA(ai, bj, At, Bt) do { __builtin_amdgcn_s_setprio(1); _Pragma("unroll") for (int m = 0; m < 4; ++m) _Pragma("unroll") for (int n = 0; n < 2; ++n) _Pragma("unroll") for (int k = 0; k < 2; ++k) \
        acc[ai][bj][m][n] = __builtin_amdgcn_mfma_f32_16x16x32_bf16(Bt[n][k], At[m][k], acc[ai][bj][m][n], 0, 0, 0); __builtin_amdgcn_s_setprio(0); } while (0)
#define PG8_WAIT_V(n) asm volatile("s_waitcnt vmcnt(" #n ")" ::: "memory")
#define PG8_WAIT_L(n) asm volatile("s_waitcnt lgkmcnt(" #n ")" ::: "memory")
#define PG8_BAR __builtin_amdgcn_s_barrier()
#define PG8_SCHED __builtin_amdgcn_sched_barrier(0)
    Unit cur, nxt; int ui = 0;
    if (!S.next(0, cur)) return;
    f32x4 acc[2][2][4][2];
#pragma unroll
    for (int a = 0; a < 2; ++a)
#pragma unroll
        for (int b = 0; b < 2; ++b)
#pragma unroll
            for (int m = 0; m < 4; ++m)
#pragma unroll
                for (int n = 0; n < 2; ++n) acc[a][b][m][n] = (f32x4){0.f, 0.f, 0.f, 0.f};
    bf16x8 At[4][2], B0[2][2], B1[2][2];
    const char* cA = (const char*)(cur.seg ? g.A1 : g.A0) + (size_t)cur.pm * tstep; const char* cB = (const char*)(cur.seg ? g.B1 : g.B0) + (size_t)cur.pn * tstep;
    if constexpr (SP2) {
        PG8_STAGE(PG8_SB(0, 0), cB, voffB); PG8_STAGE(PG8_SB(0, 1), cB + hstep, voffB); PG8_STAGE(PG8_SA(0, 0), cA, voffA); PG8_STAGE(PG8_SA(0, 1), cA + hstep, voffA);
        if (wr == 1) PG8_BAR;
        PG8_WAIT_V(2); PG8_BAR;
        PG8_STAGE(PG8_SB(1, 0), cB + kstep, voffB); PG8_STAGE(PG8_SA(1, 0), cA + kstep, voffA); PG8_STAGE(PG8_SB(1, 1), cB + hstep + kstep, voffB);
        PG8_WAIT_V(6); PG8_BAR;
    } else {
        PG8_STAGE(PG8_SB(0, 0), cB, voffB); PG8_STAGE(PG8_SA(0, 0), cA, voffA); PG8_STAGE(PG8_SB(0, 1), cB + hstep, voffB); PG8_STAGE(PG8_SA(0, 1), cA + hstep, voffA);
        if (wr == 1) PG8_BAR;
        PG8_WAIT_V(4); PG8_BAR;
        PG8_STAGE(PG8_SB(1, 0), cB + kstep, voffB); PG8_STAGE(PG8_SA(1, 0), cA + kstep, voffA); PG8_STAGE(PG8_SB(1, 1), cB + hstep + kstep, voffB);
        PG8_WAIT_V(6); PG8_BAR;
    }
    for (;;) {
        const bool has_next = S.next(ui + 1, nxt);
        const char* nA = has_next ? (const char*)(nxt.seg ? g.A1 : g.A0) + (size_t)nxt.pm * tstep : cA; const char* nB = has_next ? (const char*)(nxt.seg ? g.B1 : g.B0) + (size_t)nxt.pn * tstep : cB;
        for (int t = 0; t < nt; t += 2) {
            const bool last = (t == nt - 2);
            const char* a1 = cA + (size_t)(t + 1) * kstep;
            const char* a2 = last ? nA : cA + (size_t)(t + 2) * kstep; const char* b2 = last ? nB : cB + (size_t)(t + 2) * kstep;
            const char* a3 = a2 + kstep; const char* b3 = b2 + kstep;
            if constexpr (SP2) {
            PG8_LDB(B0, 0, 0); PG8_LDB(B1, 0, 1); PG8_SCHED; PG8_LDA(At, 0, 0); PG8_STAGE(PG8_SA(1, 1), a1 + hstep, voffA);
            PG8_WAIT_V(8); PG8_WAIT_L(0); PG8_BAR; PG8_MMA(0, 0, At, B0); PG8_MMA(0, 1, At, B1); PG8_BAR; PG8_SCHED;
            PG8_LDA(At, 0, 1); PG8_STAGE(PG8_SB(0, 0), b2, voffB); PG8_STAGE(PG8_SB(0, 1), b2 + hstep, voffB); PG8_STAGE(PG8_SA(0, 0), a2, voffA);
            PG8_WAIT_V(8); PG8_WAIT_L(0); PG8_BAR; PG8_MMA(1, 0, At, B0); PG8_MMA(1, 1, At, B1); PG8_BAR; PG8_SCHED;
            PG8_LDB(B0, 1, 0); PG8_LDB(B1, 1, 1); PG8_SCHED; PG8_LDA(At, 1, 0); PG8_STAGE(PG8_SA(0, 1), a2 + hstep, voffA);
            PG8_WAIT_V(8); PG8_WAIT_L(0); PG8_BAR; PG8_MMA(0, 0, At, B0); PG8_MMA(0, 1, At, B1); PG8_BAR; PG8_SCHED;
            PG8_LDA(At, 1, 1); PG8_STAGE(PG8_SB(1, 0), b3, voffB); PG8_STAGE(PG8_SB(1, 1), b3 + hstep, voffB); PG8_STAGE(PG8_SA(1, 0), a3, voffA);
            PG8_WAIT_V(8); PG8_WAIT_L(0); PG8_BAR; PG8_MMA(1, 0, At, B0); PG8_MMA(1, 1, At, B1); PG8_BAR; PG8_SCHED;
            } else {
            PG8_LDB(B0, 0, 0); PG8_SCHED; PG8_LDA(At, 0, 0); PG8_STAGE(PG8_SA(1, 1), a1 + hstep, voffA);
            PG8_WAIT_L(8); PG8_BAR; PG8_WAIT_L(0); PG8_MMA(0, 0, At, B0); PG8_BAR; PG8_SCHED;
            PG8_LDB(B1, 0, 1); PG8_STAGE(PG8_SB(0, 0), b2, voffB);
            PG8_BAR; PG8_WAIT_L(0); PG8_MMA(0, 1, At, B1); PG8_BAR;
            PG8_LDA(At, 0, 1); PG8_STAGE(PG8_SA(0, 0), a2, voffA);
            PG8_BAR; PG8_WAIT_L(0); PG8_MMA(1, 0, At, B0); PG8_BAR; PG8_SCHED;
            PG8_STAGE(PG8_SB(0, 1), b2 + hstep, voffB);
            PG8_WAIT_V(6); PG8_BAR; PG8_MMA(1, 1, At, B1); PG8_BAR;
            PG8_LDB(B0, 1, 0); PG8_SCHED; PG8_LDA(At, 1, 0); PG8_STAGE(PG8_SA(0, 1), a2 + hstep, voffA);
            PG8_WAIT_L(8); PG8_BAR; PG8_WAIT_L(0); PG8_MMA(0, 0, At, B0); PG8_BAR; PG8_SCHED;
            PG8_LDB(B1, 1, 1); PG8_STAGE(PG8_SB(1, 0), b3, voffB);
            PG8_BAR; PG8_WAIT_L(0); PG8_MMA(0, 1, At, B1); PG8_BAR;
            PG8_LDA(At, 1, 1); PG8_STAGE(PG8_SA(1, 0), a3, voffA);
            PG8_BAR; PG8_WAIT_L(0); PG8_MMA(1, 0, At, B0); PG8_BAR; PG8_SCHED;
            PG8_STAGE(PG8_SB(1, 1), b3 + hstep, voffB);
            PG8_WAIT_V(6); PG8_BAR; PG8_MMA(1, 1, At, B1); PG8_BAR;
            }
        }
        if constexpr (ALIGN_EPI) { if (wr == 0) PG8_BAR; }
        bool keep = false;
        if constexpr (Epi::DUAL) { if (cur.seg == 0) { E.mid(acc, cur, wr, wc, fr, fq); keep = true; } }
        if (!keep) E(acc, cur, wr, wc, fr, fq);
        if (!has_next) break;
        if (!keep) {
#pragma unroll
        for (int a = 0; a < 2; ++a)
#pragma unroll
            for (int b = 0; b < 2; ++b)
#pragma unroll
                for (int m = 0; m < 4; ++m)
#pragma unroll
                    for (int n = 0; n < 2; ++n) acc[a][b][m][n] = (f32x4){0.f, 0.f, 0.f, 0.f};
        }
        cur = nxt; cA = nA; cB = nB; ++ui;
        if constexpr (ALIGN_EPI) { if (wr == 1) PG8_BAR; }
    }
    PG8_WAIT_V(0);
    if constexpr (!ALIGN_EPI) { if (wr == 0) PG8_BAR; }
    PG8_BAR;
#undef PG8_SA
#undef PG8_SB
#undef PG8_STAGE
#undef PG8_LDA
#undef PG8_LDB
#undef PG8_MMA
#undef PG8_WAIT_V
#undef PG8_WAIT_L
#undef PG8_BAR
#undef PG8_SCHED
}

typedef f32x4 AccT[2][2][4][2];

struct EpiInA {
    static constexpr int PERM = 1; static constexpr bool DUAL = false;
    bf16_t *GQ, *GK, *GR, *DQ, *DK, *G1, *G2; float* LA; const float *b_alpha, *gain_q, *gain_k;
    __device__ __forceinline__ void operator()(const AccT& acc, const Unit& u, int wr, int wc, int fr, int fq) const {
        const int pn = u.pn; const int row0 = u.pm * BM + wr * 64 + fr;
        if (pn == 2) {
#pragma unroll
            for (int bj = 0; bj < 2; ++bj) { const int c = bj * HALF + wc * 32 + 8 * fq;
                const f32x4 b0 = *(const f32x4*)(b_alpha + c), b1 = *(const f32x4*)(b_alpha + c + 4);
#pragma unroll
                for (int ai = 0; ai < 2; ++ai)
#pragma unroll
                    for (int m = 0; m < 4; ++m) { float* p = LA + (size_t)(row0 + ai * HALF + m * 16) * 256 + c;
                        f32x4 v0 = acc[ai][bj][m][0] + b0, v1 = acc[ai][bj][m][1] + b1, o0, o1;
#pragma unroll
                        for (int j = 0; j < 4; ++j) { o0[j] = (fminf(v0[j], 0.f) - __logf(1.f + __expf(-fabsf(v0[j])))) * 0.0625f; o1[j] = (fminf(v1[j], 0.f) - __logf(1.f + __expf(-fabsf(v1[j])))) * 0.0625f; }
                        *(f32x4*)p = o0; *(f32x4*)(p + 4) = o1; } }
            return;
        }
        if (pn >= 5 && pn < 9) {
            const bool isq = pn < 7; bf16_t* dst = isq ? DQ : DK; const float* gain = isq ? gain_q : gain_k; const int cb = (isq ? pn - 5 : pn - 7) * 256 + 64 * wc;
            const float osc = isq ? 0.125f * LOG2E : 1.0f;
            f32x4 gv[2][2];
#pragma unroll
            for (int bj = 0; bj < 2; ++bj)
#pragma unroll
                for (int n = 0; n < 2; ++n) gv[bj][n] = *(const f32x4*)(gain + 32 * bj + 8 * fq + 4 * n);
#pragma unroll
            for (int ai = 0; ai < 2; ++ai)
#pragma unroll
                for (int m = 0; m < 4; ++m) { float ss = 0.f;
#pragma unroll
                    for (int bj = 0; bj < 2; ++bj)
#pragma unroll
                        for (int n = 0; n < 2; ++n) { const f32x4 x = acc[ai][bj][m][n]; ss += (x[0] * x[0] + x[1] * x[1]) + (x[2] * x[2] + x[3] * x[3]); }
                    ss += __shfl_xor(ss, 16); ss += __shfl_xor(ss, 32);
                    const float rn = __builtin_amdgcn_rsqf(ss * (1.0f / 64.0f) + EPS) * osc;
                    bf16_t* p = dst + (size_t)(row0 + ai * HALF + m * 16) * 512 + cb + 8 * fq;
#pragma unroll
                    for (int bj = 0; bj < 2; ++bj) { const f32x4 v0 = acc[ai][bj][m][0] * rn * gv[bj][0], v1 = acc[ai][bj][m][1] * rn * gv[bj][1];
                        u32x4 w; w.x = pk2(v0[0], v0[1]); w.y = pk2(v0[2], v0[3]); w.z = pk2(v1[0], v1[1]); w.w = pk2(v1[2], v1[3]);
                        *(u32x4*)(p + 32 * bj) = w; } }
            return;
        }
        if (pn >= 9) {
            const int cb = (pn - 9) * HALF + wc * 32 + 8 * fq;
#pragma unroll
            for (int ai = 0; ai < 2; ++ai)
#pragma unroll
                for (int m = 0; m < 4; ++m) { const size_t off = (size_t)(row0 + ai * HALF + m * 16) * 1024 + cb;
                    float rr[8], s2[8];
#pragma unroll
                    for (int n = 0; n < 2; ++n)
#pragma unroll
                        for (int j = 0; j < 4; ++j) { const float e1 = __builtin_amdgcn_exp2f(acc[ai][0][m][n][j] * -LOG2E), e2 = __builtin_amdgcn_exp2f(acc[ai][1][m][n][j] * -LOG2E);
                            const float q2 = __builtin_amdgcn_rcpf(1.0f + e2); s2[4 * n + j] = q2; rr[4 * n + j] = (1.0f + e2) * __builtin_amdgcn_rcpf(1.0f + e1); }
                    u32x4 w; w.x = pk2(rr[0], rr[1]); w.y = pk2(rr[2], rr[3]); w.z = pk2(rr[4], rr[5]); w.w = pk2(rr[6], rr[7]);
                    *(u32x4*)(G1 + off) = w;
                    w.x = pk2(s2[0], s2[1]); w.y = pk2(s2[2], s2[3]); w.z = pk2(s2[4], s2[5]); w.w = pk2(s2[6], s2[7]);
                    *(u32x4*)(G2 + off) = w; }
            return;
        }
        int mode, ldc, cb; bf16_t* dst;
        float sc = 1.f;
        if (pn == 0) { mode = 0; dst = GQ; ldc = 256; cb = 0; sc = 0.125f; }
        else if (pn == 1) { mode = 0; dst = GK; ldc = 256; cb = 0; }
        else if (pn < 5) { mode = 1; dst = GR; ldc = 512; cb = (pn - 3) * 256; }
        else { mode = 1; dst = GR; ldc = 512; cb = 0; }
#pragma unroll
        for (int ai = 0; ai < 2; ++ai)
#pragma unroll
            for (int m = 0; m < 4; ++m) { bf16_t* p = dst + (size_t)(row0 + ai * HALF + m * 16) * ldc + cb + wc * 32 + 8 * fq;
#pragma unroll
                for (int bj = 0; bj < 2; ++bj) { f32x4 v0 = acc[ai][bj][m][0], v1 = acc[ai][bj][m][1];
                    if (mode == 0) { v0 = v0 * sc; v1 = v1 * sc; }
                    else if (mode == 1) {
#pragma unroll
                        for (int j = 0; j < 4; ++j) { v0[j] = siluf_(v0[j]); v1[j] = siluf_(v1[j]); } }
                    else {
#pragma unroll
                        for (int j = 0; j < 4; ++j) { v0[j] = sigmoidf_(v0[j]); v1[j] = sigmoidf_(v1[j]); } }
                    u32x4 w; w.x = pk2(v0[0], v0[1]); w.y = pk2(v0[2], v0[3]); w.z = pk2(v1[0], v1[1]); w.w = pk2(v1[2], v1[3]);
                    *(u32x4*)(p + bj * HALF) = w; } }
    }
};

struct EpiInV {
    static constexpr int PERM = 2; static constexpr bool DUAL = false;
    bf16_t* VT;
    __device__ __forceinline__ void operator()(const AccT& acc, const Unit& u, int wr, int wc, int fr, int fq) const {
        const int ch0 = u.pm * BM + wr * 64 + fr; const int tok0 = u.pn * BM + wc * 32 + 8 * fq; const int b = tok0 >> 12, s0 = tok0 & 4095;
#pragma unroll
        for (int ai = 0; ai < 2; ++ai)
#pragma unroll
            for (int m = 0; m < 4; ++m) { bf16_t* p = VT + ((size_t)b * 1024 + ch0 + ai * HALF + m * 16) * SEQ + s0;
#pragma unroll
                for (int bj = 0; bj < 2; ++bj) { const f32x4 v0 = acc[ai][bj][m][0], v1 = acc[ai][bj][m][1];
                    u32x4 w; w.x = pk2(v0[0], v0[1]); w.y = pk2(v0[2], v0[3]); w.z = pk2(v1[0], v1[1]); w.w = pk2(v1[2], v1[3]);
                    *(u32x4*)(p + bj * HALF) = w; } }
    }
};

struct EpiMerge {
    static constexpr int PERM = 1; static constexpr bool DUAL = true;
    const bf16_t *G1, *G2; bf16_t* MIX;
    __device__ __forceinline__ void mid(AccT& acc, const Unit& u, int wr, int wc, int fr, int fq) const {
        const size_t off0 = (size_t)(u.pm * BM + wr * 64 + fr) * 1024 + u.pn * BM + wc * 32 + 8 * fq;
#pragma unroll
        for (int ai = 0; ai < 2; ++ai)
#pragma unroll
            for (int m = 0; m < 4; ++m)
#pragma unroll
                for (int bj = 0; bj < 2; ++bj) { const size_t off = off0 + (size_t)(ai * HALF + m * 16) * 1024 + bj * HALF;
                    const u32x4 a = *(const u32x4*)(G1 + off);
                    const f32x4 r0 = (f32x4){bf_lo(a.x), bf_hi(a.x), bf_lo(a.y), bf_hi(a.y)}, r1 = (f32x4){bf_lo(a.z), bf_hi(a.z), bf_lo(a.w), bf_hi(a.w)};
                    acc[ai][bj][m][0] = acc[ai][bj][m][0] * r0; acc[ai][bj][m][1] = acc[ai][bj][m][1] * r1; }
    }
    __device__ __forceinline__ void operator()(const AccT& acc, const Unit& u, int wr, int wc, int fr, int fq) const {
        const size_t off0 = (size_t)(u.pm * BM + wr * 64 + fr) * 1024 + u.pn * BM + wc * 32 + 8 * fq;
#pragma unroll
        for (int ai = 0; ai < 2; ++ai)
#pragma unroll
            for (int m = 0; m < 4; ++m)
#pragma unroll
                for (int bj = 0; bj < 2; ++bj) { const size_t off = off0 + (size_t)(ai * HALF + m * 16) * 1024 + bj * HALF;
                    const u32x4 b = *(const u32x4*)(G2 + off);
                    const f32x4 v0 = acc[ai][bj][m][0], v1 = acc[ai][bj][m][1];
                    u32x4 w; w.x = pk2(v0[0] * bf_lo(b.x), v0[1] * bf_hi(b.x)); w.y = pk2(v0[2] * bf_lo(b.y), v0[3] * bf_hi(b.y));
                    w.z = pk2(v1[0] * bf_lo(b.z), v1[1] * bf_hi(b.z)); w.w = pk2(v1[2] * bf_lo(b.w), v1[3] * bf_hi(b.w));
                    *(u32x4*)(MIX + off) = w; }
    }
};

template <bool BB, bool OB>
struct EpiResid {
    static constexpr int PERM = 1; static constexpr bool DUAL = false;
    const void* base; void* out; const float* gate;
    __device__ __forceinline__ void operator()(const AccT& acc, const Unit& u, int wr, int wc, int fr, int fq) const {
        const int row0 = u.pm * BM + wr * 64 + fr; const int col0 = u.pn * BM + wc * 32 + 8 * fq; const int b = row0 >> 12;
        f32x4 gt[2][2];
#pragma unroll
        for (int bj = 0; bj < 2; ++bj)
#pragma unroll
            for (int n = 0; n < 2; ++n) gt[bj][n] = *(const f32x4*)(gate + (size_t)b * NMOD + col0 + bj * HALF + n * 4);
#pragma unroll
        for (int ai = 0; ai < 2; ++ai)
#pragma unroll
            for (int m = 0; m < 4; ++m) { const size_t off = (size_t)(row0 + ai * HALF + m * 16) * DM + col0;
#pragma unroll
                for (int bj = 0; bj < 2; ++bj) { f32x4 b0, b1;
                    if constexpr (BB) { const u32x4 w = *(const u32x4*)((const bf16_t*)base + off + bj * HALF);
                        b0 = (f32x4){bf_lo(w.x), bf_hi(w.x), bf_lo(w.y), bf_hi(w.y)}; b1 = (f32x4){bf_lo(w.z), bf_hi(w.z), bf_lo(w.w), bf_hi(w.w)}; }
                    else { b0 = __builtin_nontemporal_load((const f32x4*)((const float*)base + off + bj * HALF)); b1 = __builtin_nontemporal_load((const f32x4*)((const float*)base + off + bj * HALF + 4)); }
                    const f32x4 o0 = b0 + gt[bj][0] * acc[ai][bj][m][0], o1 = b1 + gt[bj][1] * acc[ai][bj][m][1];
                    if constexpr (OB) { u32x4 w; w.x = pk2(o0[0], o0[1]); w.y = pk2(o0[2], o0[3]); w.z = pk2(o1[0], o1[1]); w.w = pk2(o1[2], o1[3]);
                        *(u32x4*)((bf16_t*)out + off + bj * HALF) = w; }
                    else { __builtin_nontemporal_store(o0, (f32x4*)((float*)out + off + bj * HALF)); __builtin_nontemporal_store(o1, (f32x4*)((float*)out + off + bj * HALF + 4)); } } }
    }
};

struct EpiSwiglu {
    static constexpr int PERM = 1; static constexpr bool DUAL = false;
    bf16_t* ACT;
    __device__ __forceinline__ void operator()(const AccT& acc, const Unit& u, int wr, int wc, int fr, int fq) const {
        const int row0 = u.pm * BM + wr * 64 + fr; const int col0 = u.pn * HALF + wc * 32 + 8 * fq;
#pragma unroll
        for (int ai = 0; ai < 2; ++ai)
#pragma unroll
            for (int m = 0; m < 4; ++m) { const f32x4 g0 = acc[ai][0][m][0], g1 = acc[ai][0][m][1], u0 = acc[ai][1][m][0], u1 = acc[ai][1][m][1];
                f32x4 o0, o1;
#pragma unroll
                for (int j = 0; j < 4; ++j) { o0[j] = siluf_(g0[j]) * u0[j]; o1[j] = siluf_(g1[j]) * u1[j]; }
                u32x4 w; w.x = pk2(o0[0], o0[1]); w.y = pk2(o0[2], o0[3]); w.z = pk2(o1[0], o1[1]); w.w = pk2(o1[2], o1[3]);
                *(u32x4*)(ACT + (size_t)(row0 + ai * HALF + m * 16) * FFH + col0) = w; }
    }
};
}

__device__ __forceinline__ void tr_item(const float* __restrict__ W, int ldw, int c0, int k0, bf16_t* __restrict__ WT, int K, int dst0, LAS float* scr, int lane) {
#pragma unroll
    for (int i = 0; i < 32; ++i) { const int kk = 2 * i + (lane >> 5); scr[kk * 33 + (lane & 31)] = __builtin_nontemporal_load(W + (size_t)(k0 + kk) * ldw + c0 + (lane & 31)); }
    asm volatile("s_waitcnt lgkmcnt(0)" ::: "memory");
    const int c = lane & 7;
#pragma unroll
    for (int j = 0; j < 4; ++j) { const int n = (lane >> 3) + 8 * j; const LAS float* s = scr + (8 * c) * 33 + n;
        u32x4 o; o.x = pk2(s[0 * 33], s[1 * 33]); o.y = pk2(s[2 * 33], s[3 * 33]); o.z = pk2(s[4 * 33], s[5 * 33]); o.w = pk2(s[6 * 33], s[7 * 33]);
        *(u32x4*)(WT + (size_t)(dst0 + n) * K + k0 + 8 * c) = o; }
    asm volatile("s_waitcnt lgkmcnt(0)" ::: "memory");
}

struct Args {
    const float* in[22]; float* out; unsigned char* ws; int ph_lo, ph_hi;
};

__device__ __forceinline__ int wa_src(int nb) {
    const int t = nb >> 3, q = nb & 7;
    if (t == 0) return C_GQ + 32 * q;
    if (t == 1) return C_GK + 32 * q;
    if (t == 2) return -1;
    if (t < 5) return C_GR + (t - 3) * 256 + 32 * q;
    if (t < 9) { const int base = (t < 7) ? C_DQ + (t - 5) * 256 : C_DK + (t - 7) * 256; const int bj = q >> 2, wc = q & 3; return base + 64 * wc + 32 * bj; }
    { const int u = t - 9; return ((q >> 2) ? C_G2 : C_G1) + 128 * u + 32 * (q & 3); }
}

__device__ __forceinline__ void phase0(const Args& a, LAS unsigned char* lds, int G) {
    const int tid = tid_fresh(), lane = tid & 63, wid = __builtin_amdgcn_readfirstlane(tid >> 6);
    unsigned char* ws = a.ws;
    const float* c_in = a.in[1]; const float* w_ada = a.in[2]; const float* b_ada = a.in[3];
    const float* w_in = a.in[5]; const float* w_up = a.in[6];
    float* mod = (float*)(ws + WS_MOD);
    if (blockIdx.x == 0 && tid < 64) {
        const float* lq1 = a.in[11]; const float* lk1 = a.in[12]; const float* lq2 = a.in[13]; const float* lk2 = a.in[14];
        const float s1 = wave_sum(lq1[lane] * lk1[lane]), s2 = wave_sum(lq2[lane] * lk2[lane]);
        if (lane < 16) ((unsigned*)(ws + WS_MISC))[8 + lane] = 0u;
        if (lane == 0) { ((unsigned*)(ws + WS_MISC))[0] = 0u; ((unsigned*)(ws + WS_MISC))[2] = 0u; ((float*)(ws + WS_MISC))[1] = __expf(s1) - __expf(s2) + 0.2f; }
    }
    if ((int)blockIdx.x < NMOD / 64) {
        LAS float* scT = (LAS float*)lds;
        LAS float* red = (LAS float*)(lds + 65536);
        for (int idx = tid; idx < 16 * 1024; idx += 512) { const int b = idx >> 10, k = idx & 1023; scT[k * 16 + b] = siluf_(c_in[idx]); }
        __syncthreads();
        const int n0 = blockIdx.x * 64;
        float acc[16];
#pragma unroll
        for (int b = 0; b < 16; ++b) acc[b] = 0.f;
        const float* wp = w_ada + (size_t)(wid * 128) * NMOD + n0 + lane;
#pragma unroll 8
        for (int k = 0; k < 128; ++k) { const float wv = wp[(size_t)k * NMOD]; const LAS f32x4* s4 = (const LAS f32x4*)(scT + (wid * 128 + k) * 16);
#pragma unroll
            for (int q = 0; q < 4; ++q) { const f32x4 s = s4[q]; acc[4 * q] += s[0] * wv; acc[4 * q + 1] += s[1] * wv; acc[4 * q + 2] += s[2] * wv; acc[4 * q + 3] += s[3] * wv; } }
#pragma unroll
        for (int b = 0; b < 16; ++b) red[(wid * 16 + b) * 64 + lane] = acc[b];
        __syncthreads();
        for (int o = tid; o < 1024; o += 512) { const int b = o >> 6, l = o & 63; float s = b_ada[n0 + l];
#pragma unroll
            for (int w = 0; w < 8; ++w) s += red[(w * 16 + b) * 64 + l];
            mod[(size_t)b * NMOD + n0 + l] = s; }
        __syncthreads();
    }
    LAS float* scr = (LAS float*)(lds + wid * 16384);
    const int NADA = (G > NMOD / 64) ? NMOD / 64 : G;
    const bool isada = (int)blockIdx.x < NADA;
    const int nslot = isada ? 1 : 2;
    const int slot0 = isada ? 2 * (G - NADA) * 8 + (int)blockIdx.x * 8 + wid : 2 * (((int)blockIdx.x - NADA) * 8 + wid);
    const int NSLOT = 2 * (G - NADA) * 8 + NADA * 8;
    bf16_t* WA = (bf16_t*)(ws + WS_WA); bf16_t* WV = (bf16_t*)(ws + WS_WV); bf16_t* WBG = (bf16_t*)(ws + WS_WBG); bf16_t* WBD = (bf16_t*)(ws + WS_WBD);
    bf16_t* WO = (bf16_t*)(ws + WS_WO); bf16_t* WF1 = (bf16_t*)(ws + WS_WF1); bf16_t* WF2 = (bf16_t*)(ws + WS_WF2);
    constexpr int I_A = 136 * 16, I_V = 32 * 16, I_BG = 32 * 8, I_BD = 32 * 8, I_O = 32 * 16, I_F1 = 176 * 16, I_F2 = 32 * 44;
    constexpr int NITEMS = I_A + I_V + I_BG + I_BD + I_O + I_F1 + I_F2;
    for (int itb = 0; itb < NITEMS; itb += NSLOT) for (int sl = 0; sl < nslot; ++sl) {
        const int it = itb + slot0 + sl; if (it >= NITEMS) continue;
        int r = it;
        if (r < I_A) { const int nb = r >> 4, kb = r & 15; const int src = wa_src(nb); if (src >= 0) tr_item(w_in, INCOLS, src, 64 * kb, WA, 1024, 32 * nb, scr, lane); continue; } r -= I_A;
        if (r < I_V) { const int nb = r >> 4, kb = r & 15; const int src = (nb < 16) ? C_GV + 32 * nb : C_DV + 32 * (nb - 16); tr_item(w_in, INCOLS, src, 64 * kb, WV, 1024, 32 * nb, scr, lane); continue; } r -= I_V;
        if (r < I_BG) { const int nb = r >> 3, kb = r & 7; tr_item(a.in[16], 1024, 32 * nb, 64 * kb, WBG, 512, 32 * nb, scr, lane); continue; } r -= I_BG;
        if (r < I_BD) { const int nb = r >> 3, kb = r & 7; tr_item(a.in[17], 1024, 32 * nb, 64 * kb, WBD, 512, 32 * nb, scr, lane); continue; } r -= I_BD;
        if (r < I_O) { const int nb = r >> 4, kb = r & 15; tr_item(a.in[18], 1024, 32 * nb, 64 * kb, WO, 1024, 32 * nb, scr, lane); continue; } r -= I_O;
        if (r < I_F1) { const int nb = r >> 4, kb = r & 15; const int t = nb >> 3, q = nb & 7; const int src = (q >> 2) * FFH + 128 * t + 32 * (q & 3);
            tr_item(a.in[20], 2 * FFH, src, 64 * kb, WF1, 1024, 32 * nb, scr, lane); continue; } r -= I_F1;
        { const int nb = r / 44, kb = r % 44; tr_item(a.in[21], 1024, 32 * nb, 64 * kb, WF2, FFH, 32 * nb, scr, lane); }
    }
    for (int i = blockIdx.x * 512 + tid; i < 256 * 128; i += G * 512) {
        const int j = i & 255, k0 = (i >> 8) * 8;
        float up[16];
#pragma unroll
        for (int r = 0; r < 16; ++r) up[r] = w_up[r * 256 + j];
        float o[8];
#pragma unroll
        for (int e = 0; e < 8; ++e) { const float* wr_ = w_in + (size_t)(k0 + e) * INCOLS + C_GA; float s = 0.f;
#pragma unroll
            for (int r = 0; r < 16; ++r) s += wr_[r] * up[r];
            o[e] = s; }
        u32x4 w; w.x = pk2(o[0], o[1]); w.y = pk2(o[2], o[3]); w.z = pk2(o[4], o[5]); w.w = pk2(o[6], o[7]);
        *(u32x4*)(WA + (size_t)(512 + j) * 1024 + k0) = w;
    }
}

__device__ __forceinline__ void norm_rows(const float* __restrict__ X, const float* __restrict__ g, const float* __restrict__ mod, int sh_off, int sc_off, bf16_t* __restrict__ H, int G) {
    const int tid = tid_fresh(), lane = tid & 63, wid = tid >> 6;
    const int gw = blockIdx.x * 8 + wid, NGW = G * 8;
    for (int row0 = gw; row0 < MTOK; row0 += 2 * NGW) {
        f32x4 v[2][4]; float ss[2] = {0.f, 0.f};
#pragma unroll
        for (int q = 0; q < 2; ++q) { const int rq = (row0 + q * NGW < MTOK) ? row0 + q * NGW : row0; const f32x4* xr = (const f32x4*)(X + (size_t)rq * DM) + lane;
#pragma unroll
            for (int j = 0; j < 4; ++j) v[q][j] = __builtin_nontemporal_load(xr + 64 * j); }
#pragma unroll
        for (int q = 0; q < 2; ++q)
#pragma unroll
            for (int j = 0; j < 4; ++j) ss[q] += (v[q][j][0] * v[q][j][0] + v[q][j][1] * v[q][j][1]) + (v[q][j][2] * v[q][j][2] + v[q][j][3] * v[q][j][3]);
#pragma unroll
        for (int q = 0; q < 2; ++q) { const int row = (row0 + q * NGW < MTOK) ? row0 + q * NGW : row0; const int b = row >> 12;
            const float rn = __builtin_amdgcn_rsqf(wave_sum(ss[q]) * (1.0f / DM) + EPS);
            const float* mb = mod + (size_t)b * NMOD;
            u32x2* o8 = (u32x2*)(H + (size_t)row * DM) + lane;
#pragma unroll
            for (int j = 0; j < 4; ++j) { const int c = 4 * (lane + 64 * j);
                const f32x4 gv = *(const f32x4*)(g + c), sc = *(const f32x4*)(mb + sc_off + c), sh = *(const f32x4*)(mb + sh_off + c);
                const f32x4 y = v[q][j] * rn * gv * (sc + 1.0f) + sh;
                u32x2 w; w.x = pk2(y[0], y[1]); w.y = pk2(y[2], y[3]); o8[64 * j] = w; } }
    }
}

__device__ __forceinline__ void norm_rows_bf(const bf16_t* __restrict__ X, const float* __restrict__ g, const float* __restrict__ mod, int sh_off, int sc_off, bf16_t* __restrict__ H, int G) {
    const int tid = tid_fresh(), lane = tid & 63, wid = tid >> 6;
    const int gw = blockIdx.x * 8 + wid, NGW = G * 8;
    for (int row0 = gw; row0 < MTOK; row0 += 2 * NGW) {
        u32x4 w[2][2]; float ss[2] = {0.f, 0.f};
#pragma unroll
        for (int q = 0; q < 2; ++q) { const int rq = (row0 + q * NGW < MTOK) ? row0 + q * NGW : row0; const u32x4* xr = (const u32x4*)(X + (size_t)rq * DM + 16 * lane);
            w[q][0] = xr[0]; w[q][1] = xr[1]; }
#pragma unroll
        for (int q = 0; q < 2; ++q) { const int row = (row0 + q * NGW < MTOK) ? row0 + q * NGW : row0; const int b = row >> 12;
            float v[16];
#pragma unroll
            for (int e = 0; e < 2; ++e) { v[8 * e] = bf_lo(w[q][e].x); v[8 * e + 1] = bf_hi(w[q][e].x); v[8 * e + 2] = bf_lo(w[q][e].y); v[8 * e + 3] = bf_hi(w[q][e].y);
                v[8 * e + 4] = bf_lo(w[q][e].z); v[8 * e + 5] = bf_hi(w[q][e].z); v[8 * e + 6] = bf_lo(w[q][e].w); v[8 * e + 7] = bf_hi(w[q][e].w); }
#pragma unroll
            for (int i = 0; i < 16; ++i) ss[q] += v[i] * v[i];
            const float rn = __builtin_amdgcn_rsqf(wave_sum(ss[q]) * (1.0f / DM) + EPS);
            const float* mb = mod + (size_t)b * NMOD; const int c = 16 * lane;
            unsigned o[8];
#pragma unroll
            for (int j = 0; j < 4; ++j) { const f32x4 gv = *(const f32x4*)(g + c + 4 * j), sc = *(const f32x4*)(mb + sc_off + c + 4 * j), sh = *(const f32x4*)(mb + sh_off + c + 4 * j);
                const f32x4 x = (f32x4){v[4 * j], v[4 * j + 1], v[4 * j + 2], v[4 * j + 3]};
                const f32x4 y = x * rn * gv * (sc + 1.0f) + sh; o[2 * j] = pk2(y[0], y[1]); o[2 * j + 1] = pk2(y[2], y[3]); }
            u32x4* op = (u32x4*)(H + (size_t)row * DM + c);
            op[0] = (u32x4){o[0], o[1], o[2], o[3]}; op[1] = (u32x4){o[4], o[5], o[6], o[7]}; }
    }
}

__device__ __forceinline__ void attn_unit(LAS unsigned char* lds, const bf16_t* __restrict__ DQ, const bf16_t* __restrict__ DK, const bf16_t* __restrict__ VT,
                                          bf16_t* __restrict__ OD, const float* __restrict__ g_out, float lam, int b, int h, int qb) {
    const int tid = tid_fresh(), lane = tid & 63, r = lane & 31, hh = lane >> 5;
    const int wid = __builtin_amdgcn_readfirstlane(tid >> 6), sub = wid & 3, map = wid >> 2;
    constexpr int STB = 32768, ST_V = 16384;
    const size_t tok0 = (size_t)b * SEQ;
    bf16x8 qf[4];
    { const bf16_t* qp = DQ + (tok0 + qb * 128 + sub * 32 + r) * 512 + h * 128 + map * 64 + hh * 8;
#pragma unroll
      for (int s = 0; s < 4; ++s) qf[s] = *(const bf16x8*)(qp + 16 * s); }
    asm volatile("" : "+v"(qf[0]), "+v"(qf[1]), "+v"(qf[2]), "+v"(qf[3]));
    const char* ksrc[2]; const char* vsrc[2];
#pragma unroll
    for (int i = 0; i < 2; ++i) { const int key = (4 * i + (lane >> 4)) & 7, c = (lane & 7) ^ key;
        const int krow = ((wid & 3) * 2 + i) * 8 + (lane >> 3), vrow = (wid * 2 + i) * 8 + (lane >> 3);
        ksrc[i] = (const char*)(DK + (tok0 + krow) * 512 + h * 128 + map * 64 + c * 8);
        vsrc[i] = (const char*)(VT + ((size_t)b * 1024 + 512 + h * 128 + vrow) * SEQ + c * 8); }
    const unsigned dbase = (unsigned)wid * 2048u;
#define AT_DMA(t, st) do { _Pragma("unroll") for (int i_ = 0; i_ < 2; ++i_) { \
        __builtin_amdgcn_global_load_lds((const unsigned*)(ksrc[i_] + (size_t)(t) * 65536), (LAS unsigned*)(lds + (st) * STB + dbase + i_ * 1024), 16, 0, 0); \
        __builtin_amdgcn_global_load_lds((const unsigned*)(vsrc[i_] + (size_t)(t) * 128), (LAS unsigned*)(lds + (st) * STB + ST_V + dbase + i_ * 1024), 16, 0, 0); } } while (0)
    const int NT = 2 * qb + 2, my_nt = (sub < 2) ? NT - 1 : NT;
    f32x16 o[4];
#pragma unroll
    for (int d = 0; d < 4; ++d)
#pragma unroll
        for (int i = 0; i < 16; ++i) o[d][i] = 0.f;
    float lsum = 0.f;
    int foff[4];
#pragma unroll
    for (int s = 0; s < 4; ++s) foff[s] = r * 128 + (((2 * s + hh) ^ ((r >> 1) & 7)) * 16);
    AT_DMA(0, 0); AT_DMA(1, 1);
    asm volatile("s_waitcnt vmcnt(0)" ::: "memory"); __builtin_amdgcn_s_barrier(); asm volatile("" ::: "memory");
    const int NP = qb + 1;
    float ls = 0.f;
#define AT_SB() __builtin_amdgcn_sched_barrier(0)
#define AT_KLD(KB) do { _Pragma("unroll") for (int s_ = 0; s_ < 4; ++s_) { kf[2 * s_] = *(const LAS bf16x8*)((KB) + foff[s_]); kf[2 * s_ + 1] = *(const LAS bf16x8*)((KB) + 4096 + foff[s_]); } } while (0)
#define AT_QK(S0, S1) do { _Pragma("unroll") for (int i_ = 0; i_ < 16; ++i_) { S0[i_] = 0.f; S1[i_] = 0.f; } \
        _Pragma("unroll") for (int s_ = 0; s_ < 4; ++s_) { S0 = __builtin_amdgcn_mfma_f32_32x32x16_bf16(kf[2 * s_], qf[s_], S0, 0, 0, 0); \
            S1 = __builtin_amdgcn_mfma_f32_32x32x16_bf16(kf[2 * s_ + 1], qf[s_], S1, 0, 0, 0); } } while (0)
#define AT_EXPBLK(SV, Q, OUT) do { _Pragma("unroll") for (int i_ = 0; i_ < 8; ++i_) { SV[(Q) + i_] = __builtin_amdgcn_exp2f(SV[(Q) + i_]); } \
        ls += ((SV[(Q)] + SV[(Q) + 1]) + (SV[(Q) + 2] + SV[(Q) + 3])) + ((SV[(Q) + 4] + SV[(Q) + 5]) + (SV[(Q) + 6] + SV[(Q) + 7])); \
        u32x4 w_; w_.x = pk2(SV[(Q)], SV[(Q) + 1]); w_.y = pk2(SV[(Q) + 2], SV[(Q) + 3]); w_.z = pk2(SV[(Q) + 4], SV[(Q) + 5]); w_.w = pk2(SV[(Q) + 6], SV[(Q) + 7]); \
        OUT = __builtin_bit_cast(bf16x8, w_); } while (0)
#define AT_PV(VF, PF) do { _Pragma("unroll") for (int dt_ = 0; dt_ < 4; ++dt_) o[dt_] = __builtin_amdgcn_mfma_f32_32x32x16_bf16(VF[dt_], PF, o[dt_], 0, 0, 0); } while (0)
#define AT_VLD(VF, VB, KS) do { _Pragma("unroll") for (int dt_ = 0; dt_ < 4; ++dt_) VF[dt_] = *(const LAS bf16x8*)((VB) + dt_ * 4096 + foff[KS]); } while (0)
#define AT_TILE(STG) do { const LAS unsigned char* kb_ = lds + (STG) * STB + map * 8192; const LAS unsigned char* vb_ = lds + (STG) * STB + ST_V; \
        f32x16 a0, a1; AT_KLD(kb_); AT_VLD(vfa, vb_, 0); AT_PV(vfb, pfn); AT_SB(); AT_QK(a0, a1); AT_SB(); AT_EXPBLK(a0, 0, pfc); AT_SB(); \
        AT_VLD(vfb, vb_, 1); AT_PV(vfa, pfc); AT_EXPBLK(a0, 8, pfn); AT_SB(); \
        AT_VLD(vfa, vb_, 2); AT_PV(vfb, pfn); AT_EXPBLK(a1, 0, pfc); AT_SB(); \
        AT_VLD(vfb, vb_, 3); AT_PV(vfa, pfc); AT_EXPBLK(a1, 8, pfn); AT_SB(); } while (0)
    bf16x8 kf[8], vfa[4], vfb[4], pfc, pfn;
#pragma unroll
    for (int i = 0; i < 8; ++i) { pfn[i] = 0;
#pragma unroll
        for (int dt = 0; dt < 4; ++dt) vfb[dt][i] = 0; }
    for (int j = 0; j < NP - 1; ++j) {
        const int st0 = (j & 1) * 2, sn = ((j + 1) & 1) * 2;
        const LAS unsigned char* kb0 = lds + st0 * STB + map * 8192; const LAS unsigned char* vb0 = lds + st0 * STB + ST_V;
        const LAS unsigned char* kb1 = kb0 + STB; const LAS unsigned char* vb1 = vb0 + STB;
        f32x16 a0, a1, b0, b1;
        AT_DMA(2 * j + 2, sn); AT_KLD(kb0); AT_VLD(vfa, vb0, 0); AT_PV(vfb, pfn); AT_SB();
        AT_QK(a0, a1); AT_SB();
        AT_DMA(2 * j + 3, sn + 1); AT_KLD(kb1); AT_SB();
        AT_QK(b0, b1); AT_EXPBLK(a0, 0, pfc); AT_SB();
        AT_VLD(vfb, vb0, 1); AT_PV(vfa, pfc); AT_EXPBLK(a0, 8, pfn); AT_SB();
        AT_VLD(vfa, vb0, 2); AT_PV(vfb, pfn); AT_EXPBLK(a1, 0, pfc); AT_SB();
        AT_VLD(vfb, vb0, 3); AT_PV(vfa, pfc); AT_EXPBLK(a1, 8, pfn); AT_SB();
        AT_VLD(vfa, vb1, 0); AT_PV(vfb, pfn); AT_EXPBLK(b0, 0, pfc); AT_SB();
        AT_VLD(vfb, vb1, 1); AT_PV(vfa, pfc); AT_EXPBLK(b0, 8, pfn); AT_SB();
        AT_VLD(vfa, vb1, 2); AT_PV(vfb, pfn); AT_EXPBLK(b1, 0, pfc); AT_SB();
        AT_VLD(vfb, vb1, 3); AT_PV(vfa, pfc); AT_EXPBLK(b1, 8, pfn); AT_SB();
        asm volatile("s_waitcnt vmcnt(0)" ::: "memory");
        __builtin_amdgcn_s_barrier(); asm volatile("" ::: "memory");
    }
    {
        const int st0 = ((NP - 1) & 1) * 2;
        AT_TILE(st0);
        if (sub >= 2) AT_TILE(st0 + 1);
        AT_PV(vfb, pfn);
        __builtin_amdgcn_s_barrier(); asm volatile("" ::: "memory");
    }
    lsum += ls;
#undef AT_SB
#undef AT_KLD
#undef AT_QK
#undef AT_EXPBLK
#undef AT_PV
#undef AT_VLD
#undef AT_TILE
#undef AT_DMA
    lsum += __shfl_xor(lsum, 32);
    const float rl = 1.0f / lsum;
    LAS float* xch = (LAS float*)lds;
    if (map == 1) {
#pragma unroll
        for (int dt = 0; dt < 4; ++dt)
#pragma unroll
            for (int i = 0; i < 16; ++i) xch[((sub * 4 + dt) * 16 + i) * 64 + lane] = o[dt][i] * rl;
    }
    __syncthreads();
    if (map == 0) {
        float ss = 0.f;
#pragma unroll
        for (int dt = 0; dt < 4; ++dt)
#pragma unroll
            for (int i = 0; i < 16; ++i) { const float v = o[dt][i] * rl - lam * xch[((sub * 4 + dt) * 16 + i) * 64 + lane]; o[dt][i] = v; ss += v * v; }
        ss += __shfl_xor(ss, 32);
        const float rn = __builtin_amdgcn_rsqf(ss * (1.0f / 128.0f) + EPS) * 0.8f;
        LAS unsigned char* stg = lds + 65536 + sub * (32 * 272);
#pragma unroll
        for (int dt = 0; dt < 4; ++dt)
#pragma unroll
            for (int g4 = 0; g4 < 4; ++g4) { const int dv0 = 32 * dt + 8 * g4 + 4 * hh; const f32x4 gv = *(const f32x4*)(g_out + dv0);
                u32x2 w; w.x = pk2(o[dt][4 * g4] * rn * gv[0], o[dt][4 * g4 + 1] * rn * gv[1]); w.y = pk2(o[dt][4 * g4 + 2] * rn * gv[2], o[dt][4 * g4 + 3] * rn * gv[3]);
                *(LAS u32x2*)(stg + r * 272 + dv0 * 2) = w; }
        asm volatile("s_waitcnt lgkmcnt(0)" ::: "memory");
        bf16_t* op = OD + (tok0 + qb * 128 + sub * 32) * 512 + h * 128;
#pragma unroll
        for (int i = 0; i < 8; ++i) { const int row = i * 4 + (lane >> 4), ch = lane & 15;
            const u32x4 v = *(const LAS u32x4*)(stg + row * 272 + ch * 16);
            *(u32x4*)(op + (size_t)row * 512 + ch * 8) = v; }
    }
    __syncthreads();
}

__device__ __forceinline__ void gla_item(LAS unsigned char* lds, const bf16_t* __restrict__ GQ, const bf16_t* __restrict__ GK, const float* __restrict__ LA,
                                         const bf16_t* __restrict__ VT, const bf16_t* __restrict__ GR, const float* __restrict__ g_out, bf16_t* __restrict__ OG, int b, int h) {
    constexpr int KP = 144;
    constexpr int O_QF = 0, O_QB = 9216, O_KF = 18432, O_KB = 27648, O_KDT = 36864, O_VT = 46080, O_ST = 64512, O_AL = 82944, O_SEG = 92160, O_DEC = 100352, O_SSQ = 100608, O_GR = 102400, O_OS = 119808, GP = 272;
    const int tid = tid_fresh(), lane = tid & 63, r = lane & 31, hh = lane >> 5;
    const int wid = __builtin_amdgcn_readfirstlane(tid >> 6);
    const int dp = tid & 31, sg = tid >> 5;
    const int dkt = wid >> 2, dvt = wid & 3, lt = wid >> 2;
    LAS f32x2* segtot = (LAS f32x2*)(lds + O_SEG); LAS float* dec = (LAS float*)(lds + O_DEC); LAS float* ssq = (LAS float*)(lds + O_SSQ);
    f32x16 S;
#pragma unroll
    for (int i = 0; i < 16; ++i) S[i] = 0.f;
    const size_t rbase = (size_t)b * SEQ * 256 + (size_t)(4 * sg) * 256 + h * 64 + 2 * dp;
    const bf16_t* vbase0 = VT + ((size_t)b * 1024 + h * 128 + (tid >> 3)) * SEQ + (tid & 7) * 8;
    f32x2 cum[4], la_n[4]; unsigned q_n[4], k_n[4]; u32x4 v_n[2], g_n[2];
    const int goff = (tid >> 4) * 512 + (tid & 15) * 8;
    const bf16_t* gbase0 = GR + (size_t)b * SEQ * 512 + h * 128;
    bf16_t* obase0 = OG + (size_t)b * SEQ * 512 + h * 128;
#pragma unroll
    for (int i = 0; i < 4; ++i) { cum[i] = *(const f32x2*)(LA + rbase + i * 256); la_n[i] = *(const f32x2*)(LA + rbase + 64 * 256 + i * 256);
        q_n[i] = *(const unsigned*)(GQ + rbase + i * 256); k_n[i] = *(const unsigned*)(GK + rbase + i * 256); }
#pragma unroll
    for (int j = 0; j < 2; ++j) { v_n[j] = *(const u32x4*)(vbase0 + (size_t)j * 64 * SEQ); g_n[j] = *(const u32x4*)(gbase0 + goff + j * 32 * 512); }
#pragma unroll
    for (int i = 1; i < 4; ++i) cum[i] += cum[i - 1];
    segtot[sg * 32 + dp] = cum[3];
    __syncthreads();
    for (int n = 0; n < SEQ / 64; ++n) {
        const size_t t0 = (size_t)b * SEQ + 64 * n;
        LAS f32x2* segc = segtot + (n & 1) * 512; LAS f32x2* segn = segtot + ((n + 1) & 1) * 512;
        {
            f32x2 prefix = {0.f, 0.f}, total = {0.f, 0.f};
#pragma unroll 4
            for (int s = 0; s < 16; ++s) { const f32x2 v = segc[s * 32 + dp]; total += v; if (s < sg) prefix += v; }
            f32x2 etot; etot.x = __expf(total.x); etot.y = __expf(total.y);
            float kd0[4], kd1[4];
#pragma unroll
            for (int i = 0; i < 4; ++i) { const f32x2 cm = prefix + cum[i]; f32x2 ep, em; ep.x = __expf(cm.x); ep.y = __expf(cm.y);
                em.x = __builtin_amdgcn_rcpf(ep.x); em.y = __builtin_amdgcn_rcpf(ep.y);
                const float q0 = bf_lo(q_n[i]), q1 = bf_hi(q_n[i]), k0 = bf_lo(k_n[i]), k1 = bf_hi(k_n[i]);
                const int o = (4 * sg + i) * KP + dp * 4;
                *(LAS unsigned*)(lds + O_QF + o) = pk2(q0 * ep.x, q1 * ep.y);
                *(LAS unsigned*)(lds + O_QB + o) = pk2(q0 * em.x, q1 * em.y);
                *(LAS unsigned*)(lds + O_KF + o) = pk2(k0 * em.x, k1 * em.y);
                *(LAS unsigned*)(lds + O_KB + o) = pk2(k0 * ep.x, k1 * ep.y);
                kd0[i] = k0 * (etot.x * em.x); kd1[i] = k1 * (etot.y * em.y); }
            u32x2 w0, w1; w0.x = pk2(kd0[0], kd0[1]); w0.y = pk2(kd0[2], kd0[3]); w1.x = pk2(kd1[0], kd1[1]); w1.y = pk2(kd1[2], kd1[3]);
            *(LAS u32x2*)(lds + O_KDT + (2 * dp) * KP + sg * 8) = w0;
            *(LAS u32x2*)(lds + O_KDT + (2 * dp + 1) * KP + sg * 8) = w1;
            if (sg == 0) { dec[2 * dp] = etot.x; dec[2 * dp + 1] = etot.y; }
#pragma unroll
            for (int j = 0; j < 2; ++j) { const int c = tid + 512 * j; const int ch = c & 7; LAS unsigned char* vp = lds + O_VT + (c >> 3) * KP + ((ch >> 1) * 16 + (ch & 1) * 4) * 2;
                u32x2 lo, hi; lo.x = v_n[j].x; lo.y = v_n[j].y; hi.x = v_n[j].z; hi.y = v_n[j].w; *(LAS u32x2*)vp = lo; *(LAS u32x2*)(vp + 16) = hi; }
            { const int n1 = (n + 1 < SEQ / 64) ? n + 1 : n;
#pragma unroll
              for (int i = 0; i < 4; ++i) { const size_t o1 = rbase + (size_t)n1 * 64 * 256 + i * 256; q_n[i] = *(const unsigned*)(GQ + o1); k_n[i] = *(const unsigned*)(GK + o1); }
#pragma unroll
              for (int j = 0; j < 2; ++j) v_n[j] = *(const u32x4*)(vbase0 + (size_t)j * 64 * SEQ + 64 * n1); }
        }
        __syncthreads();
        if (wid < 4) {
            const int ltile = (wid == 1 || wid == 2) ? 1 : 0, mtile = (wid == 1 || wid == 3) ? 1 : 0;
            const bool needf = (wid != 3), needb = (wid != 2);
            f32x16 af, ab;
#pragma unroll
            for (int i = 0; i < 16; ++i) { af[i] = 0.f; ab[i] = 0.f; }
            const int ko = (32 * mtile + r) * KP + hh * 16, qo = (32 * ltile + r) * KP + hh * 16;
            if (needf) {
#pragma unroll
                for (int s = 0; s < 4; ++s) af = __builtin_amdgcn_mfma_f32_32x32x16_bf16(*(const LAS bf16x8*)(lds + O_KF + ko + s * 32), *(const LAS bf16x8*)(lds + O_QF + qo + s * 32), af, 0, 0, 0);
            }
            if (needb) {
#pragma unroll
                for (int s = 0; s < 4; ++s) ab = __builtin_amdgcn_mfma_f32_32x32x16_bf16(*(const LAS bf16x8*)(lds + O_KB + ko + s * 32), *(const LAS bf16x8*)(lds + O_QB + qo + s * 32), ab, 0, 0, 0);
            }
            const int lg = 32 * ltile + r;
#pragma unroll
            for (int g4 = 0; g4 < 4; ++g4) { float v[4];
#pragma unroll
                for (int j = 0; j < 4; ++j) { const int mg = 32 * mtile + 8 * g4 + 4 * hh + j; v[j] = (lg >= mg) ? af[4 * g4 + j] : ab[4 * g4 + j]; }
                u32x2 w; w.x = pk2(v[0], v[1]); w.y = pk2(v[2], v[3]);
                *(LAS u32x2*)(lds + O_AL + lg * KP + (32 * mtile + 8 * g4 + 4 * hh) * 2) = w; }
        }
#pragma unroll
        for (int g4 = 0; g4 < 4; ++g4) { u32x2 w; w.x = pk2(S[4 * g4], S[4 * g4 + 1]); w.y = pk2(S[4 * g4 + 2], S[4 * g4 + 3]);
            *(LAS u32x2*)(lds + O_ST + (32 * dvt + r) * KP + (32 * dkt + 8 * g4 + 4 * hh) * 2) = w; }
#pragma unroll
        for (int j = 0; j < 2; ++j) { const int c = tid + 512 * j; *(LAS u32x4*)(lds + O_GR + (c >> 4) * GP + (c & 15) * 16) = g_n[j]; }
        { const int n1 = (n + 1 < SEQ / 64) ? n + 1 : n;
#pragma unroll
          for (int j = 0; j < 2; ++j) g_n[j] = *(const u32x4*)(gbase0 + (size_t)n1 * 64 * 512 + goff + j * 32 * 512); }
        if (n > 0) {
#pragma unroll
            for (int j = 0; j < 2; ++j) { const int c = tid + 512 * j; const u32x4 v = *(const LAS u32x4*)(lds + O_OS + (c >> 4) * GP + (c & 15) * 16);
                *(u32x4*)(obase0 + (size_t)(n - 1) * 64 * 512 + goff + j * 32 * 512) = v; }
        }
#pragma unroll
        for (int i = 0; i < 4; ++i) cum[i] = la_n[i];
#pragma unroll
        for (int i = 1; i < 4; ++i) cum[i] += cum[i - 1];
        segn[sg * 32 + dp] = cum[3];
        { const int n2 = (n + 2 < SEQ / 64) ? n + 2 : SEQ / 64 - 1;
#pragma unroll
          for (int i = 0; i < 4; ++i) la_n[i] = *(const f32x2*)(LA + rbase + (size_t)n2 * 64 * 256 + i * 256); }
        __syncthreads();
        f32x16 o;
#pragma unroll
        for (int i = 0; i < 16; ++i) o[i] = 0.f;
        {
            const int vo = (32 * dvt + r) * KP + hh * 16, lo = (32 * lt + r) * KP + hh * 16;
#pragma unroll
            for (int s = 0; s < 4; ++s) o = __builtin_amdgcn_mfma_f32_32x32x16_bf16(*(const LAS bf16x8*)(lds + O_VT + vo + s * 32), *(const LAS bf16x8*)(lds + O_AL + lo + s * 32), o, 0, 0, 0);
#pragma unroll
            for (int s = 0; s < 4; ++s) o = __builtin_amdgcn_mfma_f32_32x32x16_bf16(*(const LAS bf16x8*)(lds + O_ST + vo + s * 32), *(const LAS bf16x8*)(lds + O_QF + lo + s * 32), o, 0, 0, 0);
#pragma unroll
            for (int g4 = 0; g4 < 4; ++g4) { const f32x4 dc = *(const LAS f32x4*)(dec + 32 * dkt + 8 * g4 + 4 * hh);
#pragma unroll
                for (int j = 0; j < 4; ++j) S[4 * g4 + j] *= dc[j]; }
            const int ka = (32 * dkt + r) * KP + hh * 16;
#pragma unroll
            for (int s = 0; s < 4; ++s) S = __builtin_amdgcn_mfma_f32_32x32x16_bf16(*(const LAS bf16x8*)(lds + O_KDT + ka + s * 32), *(const LAS bf16x8*)(lds + O_VT + vo + s * 32), S, 0, 0, 0);
        }
        float ss = 0.f;
#pragma unroll
        for (int i = 0; i < 16; ++i) ss += o[i] * o[i];
        ss += __shfl_xor(ss, 32);
        if (hh == 0) ssq[(lt * 4 + dvt) * 32 + r] = ss;
        __syncthreads();
        {
            const float tot = (ssq[(lt * 4 + 0) * 32 + r] + ssq[(lt * 4 + 1) * 32 + r]) + (ssq[(lt * 4 + 2) * 32 + r] + ssq[(lt * 4 + 3) * 32 + r]);
            const float rn = __builtin_amdgcn_rsqf(tot * (1.0f / 128.0f) + EPS);
#pragma unroll
            for (int g4 = 0; g4 < 4; ++g4) { const int dv0 = 32 * dvt + 8 * g4 + 4 * hh; const int lo_ = (32 * lt + r) * GP + dv0 * 2;
                const u32x2 gt = *(const LAS u32x2*)(lds + O_GR + lo_); const f32x4 gv = *(const f32x4*)(g_out + dv0);
                u32x2 w; w.x = pk2(o[4 * g4] * rn * gv[0] * bf_lo(gt.x), o[4 * g4 + 1] * rn * gv[1] * bf_hi(gt.x));
                w.y = pk2(o[4 * g4 + 2] * rn * gv[2] * bf_lo(gt.y), o[4 * g4 + 3] * rn * gv[3] * bf_hi(gt.y));
                *(LAS u32x2*)(lds + O_OS + lo_) = w; }
        }
    }
    __syncthreads();
#pragma unroll
    for (int j = 0; j < 2; ++j) { const int c = tid + 512 * j; const u32x4 v = *(const LAS u32x4*)(lds + O_OS + (c >> 4) * GP + (c & 15) * 16);
        *(u32x4*)(obase0 + (size_t)(SEQ / 64 - 1) * 64 * 512 + goff + j * 32 * 512) = v; }
    __syncthreads();
}

#define XB_TMO      128
#define XB_XCNT(j)  (256  + 64 * (j))
#define XB_XSUB(j)  (1280 + 64 * (j))
#define XB_XGEN(j)  (2304 + 64 * (j))
#define XB_TOP      3328
#define XB_TOPGEN   3392
#define XCD_BAR_WORDS 3456
#define XB_SPIN_CAP (1u << 18)

__device__ __forceinline__ unsigned xb_ld(unsigned* p)              { return __hip_atomic_load(p, __ATOMIC_RELAXED, __HIP_MEMORY_SCOPE_AGENT); }
__device__ __forceinline__ unsigned xb_add(unsigned* p, unsigned v) { return __hip_atomic_fetch_add(p, v, __ATOMIC_RELAXED, __HIP_MEMORY_SCOPE_AGENT); }
__device__ __forceinline__ unsigned xb_xcc_id() { return (unsigned)__builtin_amdgcn_s_getreg((3 << 11) | 20) & 0xFu; }
#define XB_SPIN(cond, bar) do { unsigned _sp = 0; while (cond) { __builtin_amdgcn_s_sleep(1); \
    if ((++_sp & 255u) == 0u) { if (xb_ld(&(bar)[XB_TMO])) break; if (_sp > XB_SPIN_CAP) { atomicAdd(&(bar)[XB_TMO], 1u); break; } } } } while (0)

struct XcdBarrier {
    unsigned* bar; unsigned x;
    volatile LAS unsigned* st;
};

__device__ __forceinline__ XcdBarrier xcd_barrier_post(unsigned* bar, volatile LAS unsigned* st) {
    XcdBarrier b; b.bar = bar; b.x = xb_xcc_id(); b.st = st;
    if (threadIdx.x == 0) (void)xb_add(&bar[XB_XCNT(b.x)], 1u);
    return b;
}
__device__ __forceinline__ void xcd_barrier_complete(unsigned* bar, unsigned x, unsigned& nloc, unsigned& nx) {
    const unsigned G = gridDim.x * gridDim.y * gridDim.z;
    unsigned sum, cnt, mine, sp = 0u;
    for (;;) {
        sum = 0u; cnt = 0u; mine = 0u;
#pragma unroll
        for (unsigned j = 0; j < 16; ++j) { const unsigned c = xb_ld(&bar[XB_XCNT(j)]); sum += c; cnt += (c > 0u) ? 1u : 0u; mine = (j == x) ? c : mine; }
        if (sum == G) break;
        __builtin_amdgcn_s_sleep(1);
        if ((++sp & 255u) == 0u) { if (xb_ld(&bar[XB_TMO])) break; if (sp > XB_SPIN_CAP) { atomicAdd(&bar[XB_TMO], 1u); break; } }
    }
    nloc = mine > 0u ? mine : 1u; nx = cnt > 0u ? cnt : 1u;
}

__device__ __forceinline__ void xcd_barrier(const XcdBarrier& b) {
    asm volatile("s_waitcnt vmcnt(0)" ::: "memory");
    __syncthreads();
    if (threadIdx.x == 0) {
        unsigned* bar = b.bar;
        __builtin_amdgcn_s_waitcnt(0);
        unsigned nloc = b.st[0], nx = b.st[1];
        if (nloc == 0u) { xcd_barrier_complete(bar, b.x, nloc, nx); b.st[0] = nloc; b.st[1] = nx; }
        const unsigned old = xb_add(&bar[XB_XSUB(b.x)], 1u);
        const unsigned gen = old / nloc;
        if (old + 1u == (gen + 1u) * nloc) {
            __builtin_amdgcn_fence(__ATOMIC_RELEASE, "agent");
            asm volatile("s_waitcnt vmcnt(0)" ::: "memory");
            const unsigned og = xb_add(&bar[XB_TOP], 1u);
            const unsigned tg = og / nx;
            if (og + 1u == (tg + 1u) * nx) xb_add(&bar[XB_TOPGEN], 1u);
            else XB_SPIN(xb_ld(&bar[XB_TOPGEN]) == tg, bar);
            __builtin_amdgcn_fence(__ATOMIC_ACQUIRE, "agent");
            xb_add(&bar[XB_XGEN(b.x)], 1u);
            asm volatile("s_waitcnt vmcnt(0)" ::: "memory");
        } else {
            XB_SPIN(xb_ld(&bar[XB_XGEN(b.x)]) == gen, bar);
            __builtin_amdgcn_fence(__ATOMIC_ACQUIRE, "agent");
            asm volatile("s_waitcnt vmcnt(0)" ::: "memory");
        }
    }
    __syncthreads();
}


constexpr int NPHASE = 9;
#ifndef PROBE_MODE
#define PROBE_MODE 0
#endif
__global__ void __launch_bounds__(512, 2) fwd_kernel(Args args) {
    extern __shared__ __attribute__((aligned(16))) unsigned char lds_raw[];
    LAS unsigned char* lds = (LAS unsigned char*)lds_raw;
    cg::grid_group grid = cg::this_grid();
    const int G = gridDim.x; const int lo = args.ph_lo, hi = args.ph_hi;
    unsigned char* ws = args.ws;
    const float* x = args.in[0];
    float* mod = (float*)(ws + WS_MOD);
    bf16_t* H = (bf16_t*)(ws + WS_H);
#define IN(k) (lo <= (k) && (k) < hi)
    { volatile LAS unsigned* st0 = (volatile LAS unsigned*)(lds + 140016); if (threadIdx.x < 2) st0[threadIdx.x] = 0u; }
    __syncthreads();
    XcdBarrier xbar = xcd_barrier_post((unsigned*)(ws + WS_BAR), (volatile LAS unsigned*)(lds + 140016));
    if (lo < 0) grid.sync();
#define SEAM(k) do { if (IN(k) && IN((k) + 1)) xcd_barrier(xbar); } while (0)
    if (IN(0)) phase0(args, lds, G);
    SEAM(0);
    if (IN(1)) norm_rows(x, args.in[4], mod, 0, DM, H, G);
    SEAM(1);
    if (IN(2)) {
        { pg8::Gemm g{H, H, (const bf16_t*)(ws + WS_WA), (const bf16_t*)(ws + WS_WA), MTOK, NA, DM};
          typedef pg8::StaticOrder<MTOK / 256, NA / 256, 0> SO; SO S; S.init(G, (int)blockIdx.x);
          pg8::EpiInA E{(bf16_t*)(ws + WS_GQ), (bf16_t*)(ws + WS_GK), (bf16_t*)(ws + WS_GR), (bf16_t*)(ws + WS_DQ), (bf16_t*)(ws + WS_DK), (bf16_t*)(ws + WS_G1), (bf16_t*)(ws + WS_G2),
                        (float*)(ws + WS_LA), args.in[7], args.in[9], args.in[10]};
          pg8::gemm_phase<pg8::EpiInA, SO, true, true>(lds, g, S, E); }
        { pg8::Gemm g{(const bf16_t*)(ws + WS_WV), (const bf16_t*)(ws + WS_WV), H, H, 1024, MTOK, DM};
          typedef pg8::StaticOrder<4, MTOK / 256, 0> SO; SO S; S.init(G, (int)blockIdx.x);
          pg8::EpiInV E{(bf16_t*)(ws + WS_VT)};
          pg8::gemm_phase<pg8::EpiInV, SO, true, true>(lds, g, S, E); }
    }
    SEAM(2);
    if (IN(3)) {
        unsigned* qctr = (unsigned*)(ws + WS_MISC) + 8;
        const float lam = ((const float*)(ws + WS_MISC))[1];
        LAS unsigned* slot = (LAS unsigned*)(lds + 140000);
        for (int kq = 0; kq < 8; ++kq) {
            const int xl = ((int)blockIdx.x + kq) & 7;
            for (;;) {
                if (threadIdx.x == 0) *slot = __hip_atomic_fetch_add(qctr + xl, 1u, __ATOMIC_RELAXED, __HIP_MEMORY_SCOPE_AGENT);
                __syncthreads();
                const unsigned item = *slot;
                __syncthreads();
                if (item >= 8u + 256u) break;
                if (item < 8u) { const int bh = xl * 8 + (int)item;
                    gla_item(lds, (const bf16_t*)(ws + WS_GQ), (const bf16_t*)(ws + WS_GK), (const float*)(ws + WS_LA), (const bf16_t*)(ws + WS_VT), (const bf16_t*)(ws + WS_GR),
                             args.in[8], (bf16_t*)(ws + WS_OG), bh >> 2, bh & 3); }
                else { const unsigned a = item - 8u; const int bh = xl * 8 + (int)(a >> 5), qb = 31 - (int)(a & 31);
                    attn_unit(lds, (const bf16_t*)(ws + WS_DQ), (const bf16_t*)(ws + WS_DK), (const bf16_t*)(ws + WS_VT), (bf16_t*)(ws + WS_OD), args.in[15], lam, bh >> 2, bh & 3, qb); }
            }
        }
    }
#if PROBE_MODE == 1
    grid.sync();
    {
        unsigned* qctr = (unsigned*)(ws + WS_MISC) + 2;
        const float lam = ((const float*)(ws + WS_MISC))[1];
        LAS unsigned* slot = (LAS unsigned*)(lds + 140000);
        for (;;) {
            if (threadIdx.x == 0) *slot = __hip_atomic_fetch_add(qctr, 1u, __ATOMIC_RELAXED, __HIP_MEMORY_SCOPE_AGENT);
            __syncthreads();
            const unsigned item = *slot;
            __syncthreads();
            if (item >= 64u + 2048u) break;
            if (item < 64u) gla_item(lds, (const bf16_t*)(ws + WS_GQ), (const bf16_t*)(ws + WS_GK), (const float*)(ws + WS_LA), (const bf16_t*)(ws + WS_VT), (const bf16_t*)(ws + WS_GR),
                                     args.in[8], (bf16_t*)(ws + WS_OG), (int)(item >> 2), (int)(item & 3));
            else { const unsigned a = item - 64u; const int qb = 31 - (int)(a >> 6), bh = (int)(a & 63);
                attn_unit(lds, (const bf16_t*)(ws + WS_DQ), (const bf16_t*)(ws + WS_DK), (const bf16_t*)(ws + WS_VT), (bf16_t*)(ws + WS_OD), args.in[15], lam, bh >> 2, bh & 3, qb); }
        }
    }
#elif PROBE_MODE == 2
    grid.sync();
    if (blockIdx.x < 64) gla_item(lds, (const bf16_t*)(ws + WS_GQ), (const bf16_t*)(ws + WS_GK), (const float*)(ws + WS_LA), (const bf16_t*)(ws + WS_VT), (const bf16_t*)(ws + WS_GR),
                                     args.in[8], (bf16_t*)(ws + WS_OG), (int)(blockIdx.x >> 2), (int)(blockIdx.x & 3));
#endif
    SEAM(3);
    if (IN(4)) {
        pg8::Gemm g{(const bf16_t*)(ws + WS_OG), (const bf16_t*)(ws + WS_OD), (const bf16_t*)(ws + WS_WBG), (const bf16_t*)(ws + WS_WBD), MTOK, DM, 512};
        typedef pg8::StaticOrder<MTOK / 256, DM / 256, 1> SO; SO S; S.init(G, (int)blockIdx.x);
        pg8::EpiMerge E{(const bf16_t*)(ws + WS_G1), (const bf16_t*)(ws + WS_G2), (bf16_t*)(ws + WS_MIX)};
        pg8::gemm_phase<pg8::EpiMerge, SO, true, true>(lds, g, S, E);
    }
    SEAM(4);
    if (IN(5)) {
        pg8::Gemm g{(const bf16_t*)(ws + WS_MIX), (const bf16_t*)(ws + WS_MIX), (const bf16_t*)(ws + WS_WO), (const bf16_t*)(ws + WS_WO), MTOK, DM, DM};
        typedef pg8::StaticOrder<MTOK / 256, DM / 256, 0> SO; SO S; S.init(G, (int)blockIdx.x);
        typedef pg8::EpiResid<false, true> EP; EP E{x, (void*)(ws + WS_X1B), mod + 2 * DM};
        pg8::gemm_phase<EP, SO, true, true>(lds, g, S, E);
    }
    SEAM(5);
    if (IN(6)) norm_rows_bf((const bf16_t*)(ws + WS_X1B), args.in[19], mod, 3 * DM, 4 * DM, H, G);
    SEAM(6);
    if (IN(7)) {
        pg8::Gemm g{H, H, (const bf16_t*)(ws + WS_WF1), (const bf16_t*)(ws + WS_WF1), MTOK, 2 * FFH, DM};
        typedef pg8::StaticOrder<MTOK / 256, 2 * FFH / 256, 0> SO; SO S; S.init(G, (int)blockIdx.x);
        pg8::EpiSwiglu E{(bf16_t*)(ws + WS_ACT)};
        pg8::gemm_phase<pg8::EpiSwiglu, SO, true, true>(lds, g, S, E);
    }
    SEAM(7);
    if (IN(8)) {
        pg8::Gemm g{(const bf16_t*)(ws + WS_ACT), (const bf16_t*)(ws + WS_ACT), (const bf16_t*)(ws + WS_WF2), (const bf16_t*)(ws + WS_WF2), MTOK, DM, FFH};
        typedef pg8::StaticOrder<MTOK / 256, DM / 256, 0> SO; SO S; S.init(G, (int)blockIdx.x);
        typedef pg8::EpiResid<true, false> EP; EP E{(const void*)(ws + WS_X1B), (void*)args.out, mod + 5 * DM};
        pg8::gemm_phase<EP, SO, true, true>(lds, g, S, E);
    }
#undef IN
#undef SEAM
}

#ifndef MK_MULTI
#define MK_MULTI 0
#endif

extern "C" void kernel_launch(void* const* d_in, const int* in_sizes, int n_in, void* d_out, int out_size, void* d_ws, size_t ws_size, hipStream_t stream) {
    static int grid = 0;
    if (grid == 0) {
        if (n_in != 22 || out_size != MTOK * DM || ws_size < WS_END) { fprintf(stderr, "kernel_launch: unexpected shapes (n_in %d out %d ws %zu)\n", n_in, out_size, ws_size); grid = -1; return; }
        int dev = 0, cus = 0, per_cu = 0;
        (void)hipGetDevice(&dev);
        (void)hipDeviceGetAttribute(&cus, hipDeviceAttributeMultiprocessorCount, dev);
        if (hipFuncSetAttribute((const void*)fwd_kernel, hipFuncAttributeMaxDynamicSharedMemorySize, LDS_BYTES) != hipSuccess) { fprintf(stderr, "kernel_launch: hipFuncSetAttribute failed\n"); grid = -1; return; }
        if (hipOccupancyMaxActiveBlocksPerMultiprocessor(&per_cu, (const void*)fwd_kernel, 512, LDS_BYTES) != hipSuccess || per_cu < 1) { fprintf(stderr, "kernel_launch: occupancy query says %d\n", per_cu); per_cu = 1; }
        (void)hipGetLastError();
        grid = cus * 1;
        fprintf(stderr, "kernel_launch: grid %d (cus %d per_cu %d)\n", grid, cus, per_cu);
    }
    if (grid < 0) return;
    Args a{};
    for (int i = 0; i < 22; ++i) a.in[i] = (const float*)d_in[i];
    a.out = (float*)d_out; a.ws = (unsigned char*)d_ws;
#if MK_MULTI
    for (int p = 0; p < NPHASE; ++p) { a.ph_lo = p; a.ph_hi = p + 1; hipLaunchKernelGGL(fwd_kernel, dim3(grid), dim3(512), LDS_BYTES, stream, a); }
#else
    a.ph_lo = 0; a.ph_hi = NPHASE;
    (void)hipMemsetAsync((unsigned char*)d_ws + WS_BAR, 0, 16384, stream);
    void* kargs[] = {&a};
    hipError_t e = hipLaunchCooperativeKernel((const void*)fwd_kernel, dim3(grid), dim3(512), kargs, LDS_BYTES, stream);
    if (e != hipSuccess) fprintf(stderr, "kernel_launch: cooperative launch failed: %s (grid %d)\n", hipGetErrorString(e), grid);
#endif
}
```

```cpp
#include <hip/hip_runtime.h>
#include <hip/hip_cooperative_groups.h>
#include <cstdio>
#include <cstdint>
namespace cg = cooperative_groups;

#define LAS __attribute__((address_space(3)))
typedef unsigned short bf16_t;
typedef short bf16x8 __attribute__((ext_vector_type(8)));
typedef float f32x4 __attribute__((ext_vector_type(4)));
typedef float f32x16 __attribute__((ext_vector_type(16)));
typedef float f32x2 __attribute__((ext_vector_type(2)));
typedef unsigned u32x4 __attribute__((ext_vector_type(4)));
typedef unsigned u32x2 __attribute__((ext_vector_type(2)));
typedef __bf16 bf16x2_t __attribute__((ext_vector_type(2)));

__device__ __forceinline__ unsigned pk2(float lo, float hi) { f32x2 v = {lo, hi}; bf16x2_t b = __builtin_convertvector(v, bf16x2_t); return __builtin_bit_cast(unsigned, b); }
__device__ __forceinline__ float bf_lo(unsigned u) { return __uint_as_float(u << 16); }
__device__ __forceinline__ float bf_hi(unsigned u) { return __uint_as_float(u & 0xffff0000u); }
__device__ __forceinline__ float bf1(bf16_t u) { return __uint_as_float(((unsigned)u) << 16); }
__device__ __forceinline__ float sigmoidf_(float x) { return __builtin_amdgcn_rcpf(1.0f + __builtin_amdgcn_exp2f(x * -1.4426950408889634f)); }
__device__ __forceinline__ float siluf_(float x) { return x * __builtin_amdgcn_rcpf(1.0f + __builtin_amdgcn_exp2f(x * -1.4426950408889634f)); }
__device__ __forceinline__ int tid_fresh() { int t = threadIdx.x; asm volatile("" : "+v"(t)); return t; }
__device__ __forceinline__ int crow(int r, int hi) { return (r & 3) + 8 * (r >> 2) + 4 * hi; }
__device__ __forceinline__ float wave_sum(float v) {
#pragma unroll
    for (int o = 1; o < 64; o <<= 1) v += __shfl_xor(v, o);
    return v;
}

constexpr int BATCH = 16, SEQ = 4096, DM = 1024, MTOK = BATCH * SEQ;
constexpr int NMOD = 6 * DM;
constexpr int INCOLS = 5136;
constexpr int NA = 4352;
constexpr int FFH = 2816;
constexpr float EPS = 1e-6f;
constexpr float LOG2E = 1.4426950408889634f;
constexpr int C_GQ = 0, C_GK = 256, C_GV = 512, C_GR = 1024, C_GA = 1536, C_DQ = 1552, C_DK = 2064, C_DV = 2576, C_G1 = 3088, C_G2 = 4112;

constexpr size_t MiB = 1u << 20;
constexpr size_t WS_MOD = 0;
constexpr size_t WS_MISC = 512 * 1024;
constexpr size_t WS_BAR = 768 * 1024;
constexpr size_t WS_WA = 1 * MiB;
constexpr size_t WS_WV = 10 * MiB;
constexpr size_t WS_WBG = 12 * MiB;
constexpr size_t WS_WBD = 13 * MiB;
constexpr size_t WS_WO = 14 * MiB;
constexpr size_t WS_WF1 = 16 * MiB;
constexpr size_t WS_WF2 = 27 * MiB;
constexpr size_t WS_H = 40 * MiB;
constexpr size_t WS_GQ = 168 * MiB;
constexpr size_t WS_GK = 200 * MiB;
constexpr size_t WS_LA = 232 * MiB;
constexpr size_t WS_GR = 296 * MiB;
constexpr size_t WS_DQ = 360 * MiB;
constexpr size_t WS_DK = 424 * MiB;
constexpr size_t WS_G1 = 488 * MiB;
constexpr size_t WS_G2 = 616 * MiB;
constexpr size_t WS_VT = 744 * MiB;
constexpr size_t WS_OG = 872 * MiB;
constexpr size_t WS_OD = 936 * MiB;
constexpr size_t WS_X1B = 872 * MiB;
constexpr size_t WS_MIX = 168 * MiB;
constexpr size_t WS_ACT = 296 * MiB;
constexpr size_t WS_END = 1000 * MiB;

constexpr int LDS_BYTES = 147456;

namespace pg8 {
constexpr int BM = 256, BK = 64, HALF = 128, HTB = HALF * BK * 2, STAGE_BYTES = 8 * HTB, NXCD = 8, WGM = 8;
__host__ __device__ __forceinline__ int lds_byte(int r, int c) { const int st = (r >> 4) * 2 + (c >> 5), rr = r & 15, cc = c & 31, ob = rr * 64 + cc * 2; return st * 1024 + (ob ^ (((ob >> 9) & 1) << 5)); }
__host__ __device__ __forceinline__ void stage_rc(int b, int& R, int& C) { const int st = b / 1024, sb = b % 1024, swz = sb ^ (((sb >> 9) & 1) << 5); R = (st >> 1) * 16 + swz / 64; C = (st & 1) * 32 + (swz % 64) / 2; }
__host__ __device__ __forceinline__ int perm32(int rho) { const int n = rho >> 4, i = rho & 15; return 8 * (i >> 2) + 4 * n + (i & 3); }
__host__ __device__ __forceinline__ int permV(int rho) { const int n = rho >> 4, fq = (rho >> 2) & 3, j = rho & 3; return 16 * (fq >> 1) + 8 * n + 4 * (fq & 1) + j; }

struct Unit { int pm, pn, seg; };
struct Gemm { const bf16_t* A0; const bf16_t* A1; const bf16_t* B0; const bf16_t* B1; int M, N, K; };

template <int NM, int NN, int DUALV>
struct StaticOrder {
    int G, c;
    __device__ void init(int G_, int c_) { G = G_; c = c_; }
    __device__ bool next(int i, Unit& u) const {
        constexpr int nwg = NM * NN, q = nwg / NXCD, r = nwg % NXCD, nig = WGM * NN;
        const int it = DUALV ? (i >> 1) : i;
        const long L = (long)it * G + c; if (L >= nwg) return false;
        int wgid = (int)L; { const int xcd = wgid % NXCD, off = wgid / NXCD; wgid = (xcd < r ? xcd * (q + 1) : r * (q + 1) + (xcd - r) * q) + off; }
        const int gid = wgid / nig, fm = gid * WGM, rem = wgid % nig;
        if constexpr (NM % WGM == 0) { u.pm = fm + (rem % WGM); u.pn = rem / WGM; }
        else { const int gsz = (NM - fm) < WGM ? (NM - fm) : WGM; u.pm = fm + (rem % gsz); u.pn = rem / gsz; }
        u.seg = DUALV ? (i & 1) : 0; return true;
    }
};

template <class Epi, class Sched, bool ALIGN_EPI, bool SP2>
__device__ __forceinline__ void gemm_phase(LAS unsigned char* lds, const Gemm g, const Sched& S, const Epi& E) {
    const int tid = tid_fresh(), wid = __builtin_amdgcn_readfirstlane(tid >> 6), lane = tid & 63, wr = wid >> 2, wc = wid & 3, fr = lane & 15, fq = lane >> 4;
    const int K = g.K, nt = K / BK;
    unsigned voffA[2], voffB[2];
#pragma unroll
    for (int i = 0; i < 2; ++i) { int R, C; stage_rc(tid * 16 + i * 8192, R, C); const int Rb = (Epi::PERM == 2) ? ((R & ~31) + permV(R & 31)) : (Epi::PERM == 1) ? ((R & ~31) + perm32(R & 31)) : R;
        voffA[i] = (unsigned)(R * K + C) * 2u; voffB[i] = (unsigned)(Rb * K + C) * 2u; }
    const size_t kstep = (size_t)(BK * 2);
    const size_t hstep = (size_t)HALF * K * 2;
    const size_t tstep = 2 * hstep;
    const unsigned ldsw = (unsigned)wid * 1024u;
    const int aoff = lds_byte(wr * 64 + fr, fq * 8), boff = lds_byte(wc * 32 + fr, fq * 8);
#define PG8_SA(b, h) (((b) * 2 + (h)) * HTB)
#define PG8_SB(b, h) ((4 + (b) * 2 + (h)) * HTB)
#define PG8_STAGE(bufoff, gbase, voff) do { _Pragma("unroll") for (int _i = 0; _i < 2; ++_i) \
        __builtin_amdgcn_global_load_lds((const unsigned*)((const char*)(gbase) + (voff)[_i]), (LAS unsigned*)(lds + (bufoff) + ldsw + _i * 8192), 16, 0, 0); } while (0)
#define PG8_LDA(dst, b, h) do { _Pragma("unroll") for (int m = 0; m < 4; ++m) _Pragma("unroll") for (int k = 0; k < 2; ++k) dst[m][k] = *(const LAS bf16x8*)(lds + PG8_SA(b, h) + aoff + m * 2048 + k * 1024); } while (0)
#define PG8_LDB(dst, b, h) do { _Pragma("unroll") for (int n = 0; n < 2; ++n) _Pragma("unroll") for (int k = 0; k < 2; ++k) dst[n][k] = *(const LAS bf16x8*)(lds + PG8_SB(b, h) + boff + n * 2048 + k * 1024); } while (0)
#define PG8_MMA(ai, bj, At, Bt) do { __builtin_amdgcn_s_setprio(1); _Pragma("unroll") for (int m = 0; m < 4; ++m) _Pragma("unroll") for (int n = 0; n < 2; ++n) _Pragma("unroll") for (int k = 0; k < 2; ++k) \
        acc[ai][bj][m][n] = __builtin_amdgcn_mfma_f32_16x16x32_bf16(Bt[n][k], At[m][k], acc[ai][bj][m][n], 0, 0, 0); __builtin_amdgcn_s_setprio(0); } while (0)
#define PG8_WAIT_V(n) asm volatile("s_waitcnt vmcnt(" #n ")" ::: "memory")
#define PG8_WAIT_L(n) asm volatile("s_waitcnt lgkmcnt(" #n ")" ::: "memory")
#define PG8_BAR __builtin_amdgcn_s_barrier()
#define PG8_SCHED __builtin_amdgcn_sched_barrier(0)
    Unit cur, nxt; int ui = 0;
    if (!S.next(0, cur)) return;
    f32x4 acc[2][2][4][2];
#pragma unroll
    for (int a = 0; a < 2; ++a)
#pragma unroll
        for (int b = 0; b < 2; ++b)
#pragma unroll
            for (int m = 0; m < 4; ++m)
#pragma unroll
                for (int n = 0; n < 2; ++n) acc[a][b][m][n] = (f32x4){0.f, 0.f, 0.f, 0.f};
    bf16x8 At[4][2], B0[2][2], B1[2][2];
    const char* cA = (const char*)(cur.seg ? g.A1 : g.A0) + (size_t)cur.pm * tstep; const char* cB = (const char*)(cur.seg ? g.B1 : g.B0) + (size_t)cur.pn * tstep;
    if constexpr (SP2) {
        PG8_STAGE(PG8_SB(0, 0), cB, voffB); PG8_STAGE(PG8_SB(0, 1), cB + hstep, voffB); PG8_STAGE(PG8_SA(0, 0), cA, voffA); PG8_STAGE(PG8_SA(0, 1), cA + hstep, voffA);
        if (wr == 1) PG8_BAR;
        PG8_WAIT_V(2); PG8_BAR;
        PG8_STAGE(PG8_SB(1, 0), cB + kstep, voffB); PG8_STAGE(PG8_SA(1, 0), cA + kstep, voffA); PG8_STAGE(PG8_SB(1, 1), cB + hstep + kstep, voffB);
        PG8_WAIT_V(6); PG8_BAR;
    } else {
        PG8_STAGE(PG8_SB(0, 0), cB, voffB); PG8_STAGE(PG8_SA(0, 0), cA, voffA); PG8_STAGE(PG8_SB(0, 1), cB + hstep, voffB); PG8_STAGE(PG8_SA(0, 1), cA + hstep, voffA);
        if (wr == 1) PG8_BAR;
        PG8_WAIT_V(4); PG8_BAR;
        PG8_STAGE(PG8_SB(1, 0), cB + kstep, voffB); PG8_STAGE(PG8_SA(1, 0), cA + kstep, voffA); PG8_STAGE(PG8_SB(1, 1), cB + hstep + kstep, voffB);
        PG8_WAIT_V(6); PG8_BAR;
    }
    for (;;) {
        const bool has_next = S.next(ui + 1, nxt);
        const char* nA = has_next ? (const char*)(nxt.seg ? g.A1 : g.A0) + (size_t)nxt.pm * tstep : cA; const char* nB = has_next ? (const char*)(nxt.seg ? g.B1 : g.B0) + (size_t)nxt.pn * tstep : cB;
        for (int t = 0; t < nt; t += 2) {
            const bool last = (t == nt - 2);
            const char* a1 = cA + (size_t)(t + 1) * kstep;
            const char* a2 = last ? nA : cA + (size_t)(t + 2) * kstep; const char* b2 = last ? nB : cB + (size_t)(t + 2) * kstep;
            const char* a3 = a2 + kstep; const char* b3 = b2 + kstep;
            if constexpr (SP2) {
            PG8_STAGE(PG8_SA(1, 1), a1 + hstep, voffA); PG8_LDB(B0, 0, 0); PG8_LDB(B1, 0, 1); PG8_SCHED; PG8_LDA(At, 0, 0);
            PG8_WAIT_V(8); PG8_WAIT_L(0); PG8_BAR; PG8_MMA(0, 0, At, B0); PG8_MMA(0, 1, At, B1); PG8_BAR; PG8_SCHED;
            PG8_STAGE(PG8_SB(0, 0), b2, voffB); PG8_STAGE(PG8_SB(0, 1), b2 + hstep, voffB); PG8_STAGE(PG8_SA(0, 0), a2, voffA); PG8_LDA(At, 0, 1);
            PG8_WAIT_V(8); PG8_WAIT_L(0); PG8_BAR; PG8_MMA(1, 0, At, B0); PG8_MMA(1, 1, At, B1); PG8_BAR; PG8_SCHED;
            PG8_STAGE(PG8_SA(0, 1), a2 + hstep, voffA); PG8_LDB(B0, 1, 0); PG8_LDB(B1, 1, 1); PG8_SCHED; PG8_LDA(At, 1, 0);
            PG8_WAIT_V(8); PG8_WAIT_L(0); PG8_BAR; PG8_MMA(0, 0, At, B0); PG8_MMA(0, 1, At, B1); PG8_BAR; PG8_SCHED;
            PG8_STAGE(PG8_SB(1, 0), b3, voffB); PG8_STAGE(PG8_SB(1, 1), b3 + hstep, voffB); PG8_STAGE(PG8_SA(1, 0), a3, voffA); PG8_LDA(At, 1, 1);
            PG8_WAIT_V(8); PG8_WAIT_L(0); PG8_BAR; PG8_MMA(1, 0, At, B0); PG8_MMA(1, 1, At, B1); PG8_BAR; PG8_SCHED;
            } else {
            PG8_LDB(B0, 0, 0); PG8_SCHED; PG8_LDA(At, 0, 0); PG8_STAGE(PG8_SA(1, 1), a1 + hstep, voffA);
            PG8_WAIT_L(8); PG8_BAR; PG8_WAIT_L(0); PG8_MMA(0, 0, At, B0); PG8_BAR; PG8_SCHED;
            PG8_LDB(B1, 0, 1); PG8_STAGE(PG8_SB(0, 0), b2, voffB);
            PG8_BAR; PG8_WAIT_L(0); PG8_MMA(0, 1, At, B1); PG8_BAR;
            PG8_LDA(At, 0, 1); PG8_STAGE(PG8_SA(0, 0), a2, voffA);
            PG8_BAR; PG8_WAIT_L(0); PG8_MMA(1, 0, At, B0); PG8_BAR; PG8_SCHED;
            PG8_STAGE(PG8_SB(0, 1), b2 + hstep, voffB);
            PG8_WAIT_V(6); PG8_BAR; PG8_MMA(1, 1, At, B1); PG8_BAR;
            PG8_LDB(B0, 1, 0); PG8_SCHED; PG8_LDA(At, 1, 0); PG8_STAGE(PG8_SA(0, 1), a2 + hstep, voffA);
            PG8_WAIT_L(8); PG8_BAR; PG8_WAIT_L(0); PG8_MMA(0, 0, At, B0); PG8_BAR; PG8_SCHED;
            PG8_LDB(B1, 1, 1); PG8_STAGE(PG8_SB(1, 0), b3, voffB);
            PG8_BAR; PG8_WAIT_L(0); PG8_MMA(0, 1, At, B1); PG8_BAR;
            PG8_LDA(At, 1, 1); PG8_STAGE(PG8_SA(1, 0), a3, voffA);
            PG8_BAR; PG8_WAIT_L(0); PG8_MMA(1, 0, At, B0); PG8_BAR; PG8_SCHED;
            PG8_STAGE(PG8_SB(1, 1), b3 + hstep, voffB);
            PG8_WAIT_V(6); PG8_BAR; PG8_MMA(1, 1, At, B1); PG8_BAR;
            }
        }
        if constexpr (ALIGN_EPI) { if (wr == 0) PG8_BAR; }
        bool keep = false;
        if constexpr (Epi::DUAL) { if (cur.seg == 0) { E.mid(acc, cur, wr, wc, fr, fq); keep = true; } }
        if (!keep) E(acc, cur, wr, wc, fr, fq);
        if (!has_next) break;
        if (!keep) {
#pragma unroll
        for (int a = 0; a < 2; ++a)
#pragma unroll
            for (int b = 0; b < 2; ++b)
#pragma unroll
                for (int m = 0; m < 4; ++m)
#pragma unroll
                    for (int n = 0; n < 2; ++n) acc[a][b][m][n] = (f32x4){0.f, 0.f, 0.f, 0.f};
        }
        cur = nxt; cA = nA; cB = nB; ++ui;
        if constexpr (ALIGN_EPI) { if (wr == 1) PG8_BAR; }
    }
    PG8_WAIT_V(0);
    if constexpr (!ALIGN_EPI) { if (wr == 0) PG8_BAR; }
    PG8_BAR;
#undef PG8_SA
#undef PG8_SB
#undef PG8_STAGE
#undef PG8_LDA
#undef PG8_LDB
#undef PG8_MMA
#undef PG8_WAIT_V
#undef PG8_WAIT_L
#undef PG8_BAR
#undef PG8_SCHED
}

typedef f32x4 AccT[2][2][4][2];

struct EpiInA {
    static constexpr int PERM = 1; static constexpr bool DUAL = false;
    bf16_t *GQ, *GK, *GR, *DQ, *DK, *G1, *G2; float* LA; const float *b_alpha, *gain_q, *gain_k;
    __device__ __forceinline__ void operator()(const AccT& acc, const Unit& u, int wr, int wc, int fr, int fq) const {
        const int pn = u.pn; const int row0 = u.pm * BM + wr * 64 + fr;
        if (pn == 2) {
#pragma unroll
            for (int bj = 0; bj < 2; ++bj) { const int c = bj * HALF + wc * 32 + 8 * fq;
                const f32x4 b0 = *(const f32x4*)(b_alpha + c), b1 = *(const f32x4*)(b_alpha + c + 4);
#pragma unroll
                for (int ai = 0; ai < 2; ++ai)
#pragma unroll
                    for (int m = 0; m < 4; ++m) { float* p = LA + (size_t)(row0 + ai * HALF + m * 16) * 256 + c;
                        f32x4 v0 = acc[ai][bj][m][0] + b0, v1 = acc[ai][bj][m][1] + b1, o0, o1;
#pragma unroll
                        for (int j = 0; j < 4; ++j) { o0[j] = (fminf(v0[j], 0.f) - __logf(1.f + __expf(-fabsf(v0[j])))) * 0.0625f; o1[j] = (fminf(v1[j], 0.f) - __logf(1.f + __expf(-fabsf(v1[j])))) * 0.0625f; }
                        *(f32x4*)p = o0; *(f32x4*)(p + 4) = o1; } }
            return;
        }
        if (pn >= 5 && pn < 9) {
            const bool isq = pn < 7; bf16_t* dst = isq ? DQ : DK; const float* gain = isq ? gain_q : gain_k; const int cb = (isq ? pn - 5 : pn - 7) * 256 + 64 * wc;
            const float osc = isq ? 0.125f * LOG2E : 1.0f;
            f32x4 gv[2][2];
#pragma unroll
            for (int bj = 0; bj < 2; ++bj)
#pragma unroll
                for (int n = 0; n < 2; ++n) gv[bj][n] = *(const f32x4*)(gain + 32 * bj + 8 * fq + 4 * n);
#pragma unroll
            for (int ai = 0; ai < 2; ++ai)
#pragma unroll
                for (int m = 0; m < 4; ++m) { float ss = 0.f;
#pragma unroll
                    for (int bj = 0; bj < 2; ++bj)
#pragma unroll
                        for (int n = 0; n < 2; ++n) { const f32x4 x = acc[ai][bj][m][n]; ss += (x[0] * x[0] + x[1] * x[1]) + (x[2] * x[2] + x[3] * x[3]); }
                    ss += __shfl_xor(ss, 16); ss += __shfl_xor(ss, 32);
                    const float rn = __builtin_amdgcn_rsqf(ss * (1.0f / 64.0f) + EPS) * osc;
                    bf16_t* p = dst + (size_t)(row0 + ai * HALF + m * 16) * 512 + cb + 8 * fq;
#pragma unroll
                    for (int bj = 0; bj < 2; ++bj) { const f32x4 v0 = acc[ai][bj][m][0] * rn * gv[bj][0], v1 = acc[ai][bj][m][1] * rn * gv[bj][1];
                        u32x4 w; w.x = pk2(v0[0], v0[1]); w.y = pk2(v0[2], v0[3]); w.z = pk2(v1[0], v1[1]); w.w = pk2(v1[2], v1[3]);
                        *(u32x4*)(p + 32 * bj) = w; } }
            return;
        }
        if (pn >= 9) {
            const int cb = (pn - 9) * HALF + wc * 32 + 8 * fq;
#pragma unroll
            for (int ai = 0; ai < 2; ++ai)
#pragma unroll
                for (int m = 0; m < 4; ++m) { const size_t off = (size_t)(row0 + ai * HALF + m * 16) * 1024 + cb;
                    float rr[8], s2[8];
#pragma unroll
                    for (int n = 0; n < 2; ++n)
#pragma unroll
                        for (int j = 0; j < 4; ++j) { const float e1 = __builtin_amdgcn_exp2f(acc[ai][0][m][n][j] * -LOG2E), e2 = __builtin_amdgcn_exp2f(acc[ai][1][m][n][j] * -LOG2E);
                            const float q2 = __builtin_amdgcn_rcpf(1.0f + e2); s2[4 * n + j] = q2; rr[4 * n + j] = (1.0f + e2) * __builtin_amdgcn_rcpf(1.0f + e1); }
                    u32x4 w; w.x = pk2(rr[0], rr[1]); w.y = pk2(rr[2], rr[3]); w.z = pk2(rr[4], rr[5]); w.w = pk2(rr[6], rr[7]);
                    *(u32x4*)(G1 + off) = w;
                    w.x = pk2(s2[0], s2[1]); w.y = pk2(s2[2], s2[3]); w.z = pk2(s2[4], s2[5]); w.w = pk2(s2[6], s2[7]);
                    *(u32x4*)(G2 + off) = w; }
            return;
        }
        int mode, ldc, cb; bf16_t* dst;
        float sc = 1.f;
        if (pn == 0) { mode = 0; dst = GQ; ldc = 256; cb = 0; sc = 0.125f; }
        else if (pn == 1) { mode = 0; dst = GK; ldc = 256; cb = 0; }
        else if (pn < 5) { mode = 1; dst = GR; ldc = 512; cb = (pn - 3) * 256; }
        else { mode = 1; dst = GR; ldc = 512; cb = 0; }
#pragma unroll
        for (int ai = 0; ai < 2; ++ai)
#pragma unroll
            for (int m = 0; m < 4; ++m) { bf16_t* p = dst + (size_t)(row0 + ai * HALF + m * 16) * ldc + cb + wc * 32 + 8 * fq;
#pragma unroll
                for (int bj = 0; bj < 2; ++bj) { f32x4 v0 = acc[ai][bj][m][0], v1 = acc[ai][bj][m][1];
                    if (mode == 0) { v0 = v0 * sc; v1 = v1 * sc; }
                    else if (mode == 1) {
#pragma unroll
                        for (int j = 0; j < 4; ++j) { v0[j] = siluf_(v0[j]); v1[j] = siluf_(v1[j]); } }
                    else {
#pragma unroll
                        for (int j = 0; j < 4; ++j) { v0[j] = sigmoidf_(v0[j]); v1[j] = sigmoidf_(v1[j]); } }
                    u32x4 w; w.x = pk2(v0[0], v0[1]); w.y = pk2(v0[2], v0[3]); w.z = pk2(v1[0], v1[1]); w.w = pk2(v1[2], v1[3]);
                    *(u32x4*)(p + bj * HALF) = w; } }
    }
};

struct EpiInV {
    static constexpr int PERM = 2; static constexpr bool DUAL = false;
    bf16_t* VT;
    __device__ __forceinline__ void operator()(const AccT& acc, const Unit& u, int wr, int wc, int fr, int fq) const {
        const int ch0 = u.pm * BM + wr * 64 + fr; const int tok0 = u.pn * BM + wc * 32 + 8 * fq; const int b = tok0 >> 12, s0 = tok0 & 4095;
#pragma unroll
        for (int ai = 0; ai < 2; ++ai)
#pragma unroll
            for (int m = 0; m < 4; ++m) { bf16_t* p = VT + ((size_t)b * 1024 + ch0 + ai * HALF + m * 16) * SEQ + s0;
#pragma unroll
                for (int bj = 0; bj < 2; ++bj) { const f32x4 v0 = acc[ai][bj][m][0], v1 = acc[ai][bj][m][1];
                    u32x4 w; w.x = pk2(v0[0], v0[1]); w.y = pk2(v0[2], v0[3]); w.z = pk2(v1[0], v1[1]); w.w = pk2(v1[2], v1[3]);
                    *(u32x4*)(p + bj * HALF) = w; } }
    }
};

struct EpiMerge {
    static constexpr int PERM = 1; static constexpr bool DUAL = true;
    const bf16_t *G1, *G2; bf16_t* MIX;
    __device__ __forceinline__ void mid(AccT& acc, const Unit& u, int wr, int wc, int fr, int fq) const {
        const size_t off0 = (size_t)(u.pm * BM + wr * 64 + fr) * 1024 + u.pn * BM + wc * 32 + 8 * fq;
#pragma unroll
        for (int ai = 0; ai < 2; ++ai)
#pragma unroll
            for (int m = 0; m < 4; ++m)
#pragma unroll
                for (int bj = 0; bj < 2; ++bj) { const size_t off = off0 + (size_t)(ai * HALF + m * 16) * 1024 + bj * HALF;
                    const u32x4 a = *(const u32x4*)(G1 + off);
                    const f32x4 r0 = (f32x4){bf_lo(a.x), bf_hi(a.x), bf_lo(a.y), bf_hi(a.y)}, r1 = (f32x4){bf_lo(a.z), bf_hi(a.z), bf_lo(a.w), bf_hi(a.w)};
                    acc[ai][bj][m][0] = acc[ai][bj][m][0] * r0; acc[ai][bj][m][1] = acc[ai][bj][m][1] * r1; }
    }
    __device__ __forceinline__ void operator()(const AccT& acc, const Unit& u, int wr, int wc, int fr, int fq) const {
        const size_t off0 = (size_t)(u.pm * BM + wr * 64 + fr) * 1024 + u.pn * BM + wc * 32 + 8 * fq;
#pragma unroll
        for (int ai = 0; ai < 2; ++ai)
#pragma unroll
            for (int m = 0; m < 4; ++m)
#pragma unroll
                for (int bj = 0; bj < 2; ++bj) { const size_t off = off0 + (size_t)(ai * HALF + m * 16) * 1024 + bj * HALF;
                    const u32x4 b = *(const u32x4*)(G2 + off);
                    const f32x4 v0 = acc[ai][bj][m][0], v1 = acc[ai][bj][m][1];
                    u32x4 w; w.x = pk2(v0[0] * bf_lo(b.x), v0[1] * bf_hi(b.x)); w.y = pk2(v0[2] * bf_lo(b.y), v0[3] * bf_hi(b.y));
                    w.z = pk2(v1[0] * bf_lo(b.z), v1[1] * bf_hi(b.z)); w.w = pk2(v1[2] * bf_lo(b.w), v1[3] * bf_hi(b.w));
                    *(u32x4*)(MIX + off) = w; }
    }
};

template <bool BB, bool OB>
struct EpiResid {
    static constexpr int PERM = 1; static constexpr bool DUAL = false;
    const void* base; void* out; const float* gate;
    __device__ __forceinline__ void operator()(const AccT& acc, const Unit& u, int wr, int wc, int fr, int fq) const {
        const int row0 = u.pm * BM + wr * 64 + fr; const int col0 = u.pn * BM + wc * 32 + 8 * fq; const int b = row0 >> 12;
        f32x4 gt[2][2];
#pragma unroll
        for (int bj = 0; bj < 2; ++bj)
#pragma unroll
            for (int n = 0; n < 2; ++n) gt[bj][n] = *(const f32x4*)(gate + (size_t)b * NMOD + col0 + bj * HALF + n * 4);
#pragma unroll
        for (int ai = 0; ai < 2; ++ai)
#pragma unroll
            for (int m = 0; m < 4; ++m) { const size_t off = (size_t)(row0 + ai * HALF + m * 16) * DM + col0;
#pragma unroll
                for (int bj = 0; bj < 2; ++bj) { f32x4 b0, b1;
                    if constexpr (BB) { const u32x4 w = *(const u32x4*)((const bf16_t*)base + off + bj * HALF);
                        b0 = (f32x4){bf_lo(w.x), bf_hi(w.x), bf_lo(w.y), bf_hi(w.y)}; b1 = (f32x4){bf_lo(w.z), bf_hi(w.z), bf_lo(w.w), bf_hi(w.w)}; }
                    else { b0 = __builtin_nontemporal_load((const f32x4*)((const float*)base + off + bj * HALF)); b1 = __builtin_nontemporal_load((const f32x4*)((const float*)base + off + bj * HALF + 4)); }
                    const f32x4 o0 = b0 + gt[bj][0] * acc[ai][bj][m][0], o1 = b1 + gt[bj][1] * acc[ai][bj][m][1];
                    if constexpr (OB) { u32x4 w; w.x = pk2(o0[0], o0[1]); w.y = pk2(o0[2], o0[3]); w.z = pk2(o1[0], o1[1]); w.w = pk2(o1[2], o1[3]);
                        *(u32x4*)((bf16_t*)out + off + bj * HALF) = w; }
                    else { __builtin_nontemporal_store(o0, (f32x4*)((float*)out + off + bj * HALF)); __builtin_nontemporal_store(o1, (f32x4*)((float*)out + off + bj * HALF + 4)); } } }
    }
};

struct EpiSwiglu {
    static constexpr int PERM = 1; static constexpr bool DUAL = false;
    bf16_t* ACT;
    __device__ __forceinline__ void operator()(const AccT& acc, const Unit& u, int wr, int wc, int fr, int fq) const {
        const int row0 = u.pm * BM + wr * 64 + fr; const int col0 = u.pn * HALF + wc * 32 + 8 * fq;
#pragma unroll
        for (int ai = 0; ai < 2; ++ai)
#pragma unroll
            for (int m = 0; m < 4; ++m) { const f32x4 g0 = acc[ai][0][m][0], g1 = acc[ai][0][m][1], u0 = acc[ai][1][m][0], u1 = acc[ai][1][m][1];
                f32x4 o0, o1;
#pragma unroll
                for (int j = 0; j < 4; ++j) { o0[j] = siluf_(g0[j]) * u0[j]; o1[j] = siluf_(g1[j]) * u1[j]; }
                u32x4 w; w.x = pk2(o0[0], o0[1]); w.y = pk2(o0[2], o0[3]); w.z = pk2(o1[0], o1[1]); w.w = pk2(o1[2], o1[3]);
                *(u32x4*)(ACT + (size_t)(row0 + ai * HALF + m * 16) * FFH + col0) = w; }
    }
};
}

__device__ __forceinline__ void tr_item(const float* __restrict__ W, int ldw, int c0, int k0, bf16_t* __restrict__ WT, int K, int dst0, LAS float* scr, int lane) {
#pragma unroll
    for (int i = 0; i < 32; ++i) { const int kk = 2 * i + (lane >> 5); scr[kk * 33 + (lane & 31)] = __builtin_nontemporal_load(W + (size_t)(k0 + kk) * ldw + c0 + (lane & 31)); }
    asm volatile("s_waitcnt lgkmcnt(0)" ::: "memory");
    const int c = lane & 7;
#pragma unroll
    for (int j = 0; j < 4; ++j) { const int n = (lane >> 3) + 8 * j; const LAS float* s = scr + (8 * c) * 33 + n;
        u32x4 o; o.x = pk2(s[0 * 33], s[1 * 33]); o.y = pk2(s[2 * 33], s[3 * 33]); o.z = pk2(s[4 * 33], s[5 * 33]); o.w = pk2(s[6 * 33], s[7 * 33]);
        *(u32x4*)(WT + (size_t)(dst0 + n) * K + k0 + 8 * c) = o; }
    asm volatile("s_waitcnt lgkmcnt(0)" ::: "memory");
}

struct Args {
    const float* in[22]; float* out; unsigned char* ws; int ph_lo, ph_hi;
};

__device__ __forceinline__ int wa_src(int nb) {
    const int t = nb >> 3, q = nb & 7;
    if (t == 0) return C_GQ + 32 * q;
    if (t == 1) return C_GK + 32 * q;
    if (t == 2) return -1;
    if (t < 5) return C_GR + (t - 3) * 256 + 32 * q;
    if (t < 9) { const int base = (t < 7) ? C_DQ + (t - 5) * 256 : C_DK + (t - 7) * 256; const int bj = q >> 2, wc = q & 3; return base + 64 * wc + 32 * bj; }
    { const int u = t - 9; return ((q >> 2) ? C_G2 : C_G1) + 128 * u + 32 * (q & 3); }
}

__device__ __forceinline__ void phase0(const Args& a, LAS unsigned char* lds, int G) {
    const int tid = tid_fresh(), lane = tid & 63, wid = __builtin_amdgcn_readfirstlane(tid >> 6);
    unsigned char* ws = a.ws;
    const float* c_in = a.in[1]; const float* w_ada = a.in[2]; const float* b_ada = a.in[3];
    const float* w_in = a.in[5]; const float* w_up = a.in[6];
    float* mod = (float*)(ws + WS_MOD);
    if (blockIdx.x == 0 && tid < 64) {
        const float* lq1 = a.in[11]; const float* lk1 = a.in[12]; const float* lq2 = a.in[13]; const float* lk2 = a.in[14];
        const float s1 = wave_sum(lq1[lane] * lk1[lane]), s2 = wave_sum(lq2[lane] * lk2[lane]);
        if (lane < 16) ((unsigned*)(ws + WS_MISC))[8 + lane] = 0u;
        if (lane == 0) { ((unsigned*)(ws + WS_MISC))[0] = 0u; ((unsigned*)(ws + WS_MISC))[2] = 0u; ((float*)(ws + WS_MISC))[1] = __expf(s1) - __expf(s2) + 0.2f; }
    }
    if ((int)blockIdx.x < NMOD / 64) {
        LAS float* scT = (LAS float*)lds;
        LAS float* red = (LAS float*)(lds + 65536);
        for (int idx = tid; idx < 16 * 1024; idx += 512) { const int b = idx >> 10, k = idx & 1023; scT[k * 16 + b] = siluf_(c_in[idx]); }
        __syncthreads();
        const int n0 = blockIdx.x * 64;
        float acc[16];
#pragma unroll
        for (int b = 0; b < 16; ++b) acc[b] = 0.f;
        const float* wp = w_ada + (size_t)(wid * 128) * NMOD + n0 + lane;
#pragma unroll 8
        for (int k = 0; k < 128; ++k) { const float wv = wp[(size_t)k * NMOD]; const LAS f32x4* s4 = (const LAS f32x4*)(scT + (wid * 128 + k) * 16);
#pragma unroll
            for (int q = 0; q < 4; ++q) { const f32x4 s = s4[q]; acc[4 * q] += s[0] * wv; acc[4 * q + 1] += s[1] * wv; acc[4 * q + 2] += s[2] * wv; acc[4 * q + 3] += s[3] * wv; } }
#pragma unroll
        for (int b = 0; b < 16; ++b) red[(wid * 16 + b) * 64 + lane] = acc[b];
        __syncthreads();
        for (int o = tid; o < 1024; o += 512) { const int b = o >> 6, l = o & 63; float s = b_ada[n0 + l];
#pragma unroll
            for (int w = 0; w < 8; ++w) s += red[(w * 16 + b) * 64 + l];
            mod[(size_t)b * NMOD + n0 + l] = s; }
        __syncthreads();
    }
    LAS float* scr = (LAS float*)(lds + wid * 16384);
    const int NADA = (G > NMOD / 64) ? NMOD / 64 : G;
    const bool isada = (int)blockIdx.x < NADA;
    const int nslot = isada ? 1 : 2;
    const int slot0 = isada ? 2 * (G - NADA) * 8 + (int)blockIdx.x * 8 + wid : 2 * (((int)blockIdx.x - NADA) * 8 + wid);
    const int NSLOT = 2 * (G - NADA) * 8 + NADA * 8;
    bf16_t* WA = (bf16_t*)(ws + WS_WA); bf16_t* WV = (bf16_t*)(ws + WS_WV); bf16_t* WBG = (bf16_t*)(ws + WS_WBG); bf16_t* WBD = (bf16_t*)(ws + WS_WBD);
    bf16_t* WO = (bf16_t*)(ws + WS_WO); bf16_t* WF1 = (bf16_t*)(ws + WS_WF1); bf16_t* WF2 = (bf16_t*)(ws + WS_WF2);
    constexpr int I_A = 136 * 16, I_V = 32 * 16, I_BG = 32 * 8, I_BD = 32 * 8, I_O = 32 * 16, I_F1 = 176 * 16, I_F2 = 32 * 44;
    constexpr int NITEMS = I_A + I_V + I_BG + I_BD + I_O + I_F1 + I_F2;
    for (int itb = 0; itb < NITEMS; itb += NSLOT) for (int sl = 0; sl < nslot; ++sl) {
        const int it = itb + slot0 + sl; if (it >= NITEMS) continue;
        int r = it;
        if (r < I_A) { const int nb = r >> 4, kb = r & 15; const int src = wa_src(nb); if (src >= 0) tr_item(w_in, INCOLS, src, 64 * kb, WA, 1024, 32 * nb, scr, lane); continue; } r -= I_A;
        if (r < I_V) { const int nb = r >> 4, kb = r & 15; const int src = (nb < 16) ? C_GV + 32 * nb : C_DV + 32 * (nb - 16); tr_item(w_in, INCOLS, src, 64 * kb, WV, 1024, 32 * nb, scr, lane); continue; } r -= I_V;
        if (r < I_BG) { const int nb = r >> 3, kb = r & 7; tr_item(a.in[16], 1024, 32 * nb, 64 * kb, WBG, 512, 32 * nb, scr, lane); continue; } r -= I_BG;
        if (r < I_BD) { const int nb = r >> 3, kb = r & 7; tr_item(a.in[17], 1024, 32 * nb, 64 * kb, WBD, 512, 32 * nb, scr, lane); continue; } r -= I_BD;
        if (r < I_O) { const int nb = r >> 4, kb = r & 15; tr_item(a.in[18], 1024, 32 * nb, 64 * kb, WO, 1024, 32 * nb, scr, lane); continue; } r -= I_O;
        if (r < I_F1) { const int nb = r >> 4, kb = r & 15; const int t = nb >> 3, q = nb & 7; const int src = (q >> 2) * FFH + 128 * t + 32 * (q & 3);
            tr_item(a.in[20], 2 * FFH, src, 64 * kb, WF1, 1024, 32 * nb, scr, lane); continue; } r -= I_F1;
        { const int nb = r / 44, kb = r % 44; tr_item(a.in[21], 1024, 32 * nb, 64 * kb, WF2, FFH, 32 * nb, scr, lane); }
    }
    for (int i = blockIdx.x * 512 + tid; i < 256 * 128; i += G * 512) {
        const int j = i & 255, k0 = (i >> 8) * 8;
        float up[16];
#pragma unroll
        for (int r = 0; r < 16; ++r) up[r] = w_up[r * 256 + j];
        float o[8];
#pragma unroll
        for (int e = 0; e < 8; ++e) { const float* wr_ = w_in + (size_t)(k0 + e) * INCOLS + C_GA; float s = 0.f;
#pragma unroll
            for (int r = 0; r < 16; ++r) s += wr_[r] * up[r];
            o[e] = s; }
        u32x4 w; w.x = pk2(o[0], o[1]); w.y = pk2(o[2], o[3]); w.z = pk2(o[4], o[5]); w.w = pk2(o[6], o[7]);
        *(u32x4*)(WA + (size_t)(512 + j) * 1024 + k0) = w;
    }
}

__device__ __forceinline__ void norm_rows(const float* __restrict__ X, const float* __restrict__ g, const float* __restrict__ mod, int sh_off, int sc_off, bf16_t* __restrict__ H, int G) {
    const int tid = tid_fresh(), lane = tid & 63, wid = tid >> 6;
    const int gw = blockIdx.x * 8 + wid, NGW = G * 8;
    for (int row0 = gw; row0 < MTOK; row0 += 2 * NGW) {
        f32x4 v[2][4]; float ss[2] = {0.f, 0.f};
#pragma unroll
        for (int q = 0; q < 2; ++q) { const int rq = (row0 + q * NGW < MTOK) ? row0 + q * NGW : row0; const f32x4* xr = (const f32x4*)(X + (size_t)rq * DM) + lane;
#pragma unroll
            for (int j = 0; j < 4; ++j) v[q][j] = __builtin_nontemporal_load(xr + 64 * j); }
#pragma unroll
        for (int q = 0; q < 2; ++q)
#pragma unroll
            for (int j = 0; j < 4; ++j) ss[q] += (v[q][j][0] * v[q][j][0] + v[q][j][1] * v[q][j][1]) + (v[q][j][2] * v[q][j][2] + v[q][j][3] * v[q][j][3]);
#pragma unroll
        for (int q = 0; q < 2; ++q) { const int row = (row0 + q * NGW < MTOK) ? row0 + q * NGW : row0; const int b = row >> 12;
            const float rn = __builtin_amdgcn_rsqf(wave_sum(ss[q]) * (1.0f / DM) + EPS);
            const float* mb = mod + (size_t)b * NMOD;
            u32x2* o8 = (u32x2*)(H + (size_t)row * DM) + lane;
#pragma unroll
            for (int j = 0; j < 4; ++j) { const int c = 4 * (lane + 64 * j);
                const f32x4 gv = *(const f32x4*)(g + c), sc = *(const f32x4*)(mb + sc_off + c), sh = *(const f32x4*)(mb + sh_off + c);
                const f32x4 y = v[q][j] * rn * gv * (sc + 1.0f) + sh;
                u32x2 w; w.x = pk2(y[0], y[1]); w.y = pk2(y[2], y[3]); o8[64 * j] = w; } }
    }
}

__device__ __forceinline__ void norm_rows_bf(const bf16_t* __restrict__ X, const float* __restrict__ g, const float* __restrict__ mod, int sh_off, int sc_off, bf16_t* __restrict__ H, int G) {
    const int tid = tid_fresh(), lane = tid & 63, wid = tid >> 6;
    const int gw = blockIdx.x * 8 + wid, NGW = G * 8;
    for (int row0 = gw; row0 < MTOK; row0 += 2 * NGW) {
        u32x4 w[2][2]; float ss[2] = {0.f, 0.f};
#pragma unroll
        for (int q = 0; q < 2; ++q) { const int rq = (row0 + q * NGW < MTOK) ? row0 + q * NGW : row0; const u32x4* xr = (const u32x4*)(X + (size_t)rq * DM + 16 * lane);
            w[q][0] = xr[0]; w[q][1] = xr[1]; }
#pragma unroll
        for (int q = 0; q < 2; ++q) { const int row = (row0 + q * NGW < MTOK) ? row0 + q * NGW : row0; const int b = row >> 12;
            float v[16];
#pragma unroll
            for (int e = 0; e < 2; ++e) { v[8 * e] = bf_lo(w[q][e].x); v[8 * e + 1] = bf_hi(w[q][e].x); v[8 * e + 2] = bf_lo(w[q][e].y); v[8 * e + 3] = bf_hi(w[q][e].y);
                v[8 * e + 4] = bf_lo(w[q][e].z); v[8 * e + 5] = bf_hi(w[q][e].z); v[8 * e + 6] = bf_lo(w[q][e].w); v[8 * e + 7] = bf_hi(w[q][e].w); }
#pragma unroll
            for (int i = 0; i < 16; ++i) ss[q] += v[i] * v[i];
            const float rn = __builtin_amdgcn_rsqf(wave_sum(ss[q]) * (1.0f / DM) + EPS);
            const float* mb = mod + (size_t)b * NMOD; const int c = 16 * lane;
            unsigned o[8];
#pragma unroll
            for (int j = 0; j < 4; ++j) { const f32x4 gv = *(const f32x4*)(g + c + 4 * j), sc = *(const f32x4*)(mb + sc_off + c + 4 * j), sh = *(const f32x4*)(mb + sh_off + c + 4 * j);
                const f32x4 x = (f32x4){v[4 * j], v[4 * j + 1], v[4 * j + 2], v[4 * j + 3]};
                const f32x4 y = x * rn * gv * (sc + 1.0f) + sh; o[2 * j] = pk2(y[0], y[1]); o[2 * j + 1] = pk2(y[2], y[3]); }
            u32x4* op = (u32x4*)(H + (size_t)row * DM + c);
            op[0] = (u32x4){o[0], o[1], o[2], o[3]}; op[1] = (u32x4){o[4], o[5], o[6], o[7]}; }
    }
}

__device__ __forceinline__ void attn_unit(LAS unsigned char* lds, const bf16_t* __restrict__ DQ, const bf16_t* __restrict__ DK, const bf16_t* __restrict__ VT,
                                          bf16_t* __restrict__ OD, const float* __restrict__ g_out, float lam, int b, int h, int qb) {
    const int tid = tid_fresh(), lane = tid & 63, r = lane & 31, hh = lane >> 5;
    const int wid = __builtin_amdgcn_readfirstlane(tid >> 6), sub = wid & 3, map = wid >> 2;
    constexpr int STB = 32768, ST_V = 16384;
    const size_t tok0 = (size_t)b * SEQ;
    bf16x8 qf[4];
    { const bf16_t* qp = DQ + (tok0 + qb * 128 + sub * 32 + r) * 512 + h * 128 + map * 64 + hh * 8;
#pragma unroll
      for (int s = 0; s < 4; ++s) qf[s] = *(const bf16x8*)(qp + 16 * s); }
    asm volatile("" : "+v"(qf[0]), "+v"(qf[1]), "+v"(qf[2]), "+v"(qf[3]));
    const char* ksrc[2]; const char* vsrc[2];
#pragma unroll
    for (int i = 0; i < 2; ++i) { const int key = (4 * i + (lane >> 4)) & 7, c = (lane & 7) ^ key;
        const int krow = ((wid & 3) * 2 + i) * 8 + (lane >> 3), vrow = (wid * 2 + i) * 8 + (lane >> 3);
        ksrc[i] = (const char*)(DK + (tok0 + krow) * 512 + h * 128 + map * 64 + c * 8);
        vsrc[i] = (const char*)(VT + ((size_t)b * 1024 + 512 + h * 128 + vrow) * SEQ + c * 8); }
    const unsigned dbase = (unsigned)wid * 2048u;
#define AT_DMA(t, st) do { _Pragma("unroll") for (int i_ = 0; i_ < 2; ++i_) { \
        __builtin_amdgcn_global_load_lds((const unsigned*)(ksrc[i_] + (size_t)(t) * 65536), (LAS unsigned*)(lds + (st) * STB + dbase + i_ * 1024), 16, 0, 0); \
        __builtin_amdgcn_global_load_lds((const unsigned*)(vsrc[i_] + (size_t)(t) * 128), (LAS unsigned*)(lds + (st) * STB + ST_V + dbase + i_ * 1024), 16, 0, 0); } } while (0)
    const int NT = 2 * qb + 2, my_nt = (sub < 2) ? NT - 1 : NT;
    f32x16 o[4];
#pragma unroll
    for (int d = 0; d < 4; ++d)
#pragma unroll
        for (int i = 0; i < 16; ++i) o[d][i] = 0.f;
    float lsum = 0.f;
    int foff[4];
#pragma unroll
    for (int s = 0; s < 4; ++s) foff[s] = r * 128 + (((2 * s + hh) ^ ((r >> 1) & 7)) * 16);
    AT_DMA(0, 0); AT_DMA(1, 1);
    asm volatile("s_waitcnt vmcnt(0)" ::: "memory"); __builtin_amdgcn_s_barrier(); asm volatile("" ::: "memory");
    const int NP = qb + 1;
    float ls = 0.f;
#define AT_SB() __builtin_amdgcn_sched_barrier(0)
#define AT_KLD(KB) do { _Pragma("unroll") for (int s_ = 0; s_ < 4; ++s_) { kf[2 * s_] = *(const LAS bf16x8*)((KB) + foff[s_]); kf[2 * s_ + 1] = *(const LAS bf16x8*)((KB) + 4096 + foff[s_]); } } while (0)
#define AT_QK(S0, S1) do { _Pragma("unroll") for (int i_ = 0; i_ < 16; ++i_) { S0[i_] = 0.f; S1[i_] = 0.f; } \
        _Pragma("unroll") for (int s_ = 0; s_ < 4; ++s_) { S0 = __builtin_amdgcn_mfma_f32_32x32x16_bf16(kf[2 * s_], qf[s_], S0, 0, 0, 0); \
            S1 = __builtin_amdgcn_mfma_f32_32x32x16_bf16(kf[2 * s_ + 1], qf[s_], S1, 0, 0, 0); } } while (0)
#define AT_EXPBLK(SV, Q, OUT) do { _Pragma("unroll") for (int i_ = 0; i_ < 8; ++i_) { SV[(Q) + i_] = __builtin_amdgcn_exp2f(SV[(Q) + i_]); } \
        ls += ((SV[(Q)] + SV[(Q) + 1]) + (SV[(Q) + 2] + SV[(Q) + 3])) + ((SV[(Q) + 4] + SV[(Q) + 5]) + (SV[(Q) + 6] + SV[(Q) + 7])); \
        u32x4 w_; w_.x = pk2(SV[(Q)], SV[(Q) + 1]); w_.y = pk2(SV[(Q) + 2], SV[(Q) + 3]); w_.z = pk2(SV[(Q) + 4], SV[(Q) + 5]); w_.w = pk2(SV[(Q) + 6], SV[(Q) + 7]); \
        OUT = __builtin_bit_cast(bf16x8, w_); } while (0)
#define AT_PV(VF, PF) do { _Pragma("unroll") for (int dt_ = 0; dt_ < 4; ++dt_) o[dt_] = __builtin_amdgcn_mfma_f32_32x32x16_bf16(VF[dt_], PF, o[dt_], 0, 0, 0); } while (0)
#define AT_VLD(VF, VB, KS) do { _Pragma("unroll") for (int dt_ = 0; dt_ < 4; ++dt_) VF[dt_] = *(const LAS bf16x8*)((VB) + dt_ * 4096 + foff[KS]); } while (0)
#define AT_TILE(STG) do { const LAS unsigned char* kb_ = lds + (STG) * STB + map * 8192; const LAS unsigned char* vb_ = lds + (STG) * STB + ST_V; \
        f32x16 a0, a1; AT_KLD(kb_); AT_VLD(vfa, vb_, 0); AT_PV(vfb, pfn); AT_SB(); AT_QK(a0, a1); AT_SB(); AT_EXPBLK(a0, 0, pfc); AT_SB(); \
        AT_VLD(vfb, vb_, 1); AT_PV(vfa, pfc); AT_EXPBLK(a0, 8, pfn); AT_SB(); \
        AT_VLD(vfa, vb_, 2); AT_PV(vfb, pfn); AT_EXPBLK(a1, 0, pfc); AT_SB(); \
        AT_VLD(vfb, vb_, 3); AT_PV(vfa, pfc); AT_EXPBLK(a1, 8, pfn); AT_SB(); } while (0)
    bf16x8 kf[8], vfa[4], vfb[4], pfc, pfn;
#pragma unroll
    for (int i = 0; i < 8; ++i) { pfn[i] = 0;
#pragma unroll
        for (int dt = 0; dt < 4; ++dt) vfb[dt][i] = 0; }
    for (int j = 0; j < NP - 1; ++j) {
        const int st0 = (j & 1) * 2, sn = ((j + 1) & 1) * 2;
        const LAS unsigned char* kb0 = lds + st0 * STB + map * 8192; const LAS unsigned char* vb0 = lds + st0 * STB + ST_V;
        const LAS unsigned char* kb1 = kb0 + STB; const LAS unsigned char* vb1 = vb0 + STB;
        f32x16 a0, a1, b0, b1;
        AT_DMA(2 * j + 2, sn); AT_KLD(kb0); AT_VLD(vfa, vb0, 0); AT_PV(vfb, pfn); AT_SB();
        AT_QK(a0, a1); AT_SB();
        AT_DMA(2 * j + 3, sn + 1); AT_KLD(kb1); AT_SB();
        AT_QK(b0, b1); AT_EXPBLK(a0, 0, pfc); AT_SB();
        AT_VLD(vfb, vb0, 1); AT_PV(vfa, pfc); AT_EXPBLK(a0, 8, pfn); AT_SB();
        AT_VLD(vfa, vb0, 2); AT_PV(vfb, pfn); AT_EXPBLK(a1, 0, pfc); AT_SB();
        AT_VLD(vfb, vb0, 3); AT_PV(vfa, pfc); AT_EXPBLK(a1, 8, pfn); AT_SB();
        AT_VLD(vfa, vb1, 0); AT_PV(vfb, pfn); AT_EXPBLK(b0, 0, pfc); AT_SB();
        AT_VLD(vfb, vb1, 1); AT_PV(vfa, pfc); AT_EXPBLK(b0, 8, pfn); AT_SB();
        AT_VLD(vfa, vb1, 2); AT_PV(vfb, pfn); AT_EXPBLK(b1, 0, pfc); AT_SB();
        AT_VLD(vfb, vb1, 3); AT_PV(vfa, pfc); AT_EXPBLK(b1, 8, pfn); AT_SB();
        asm volatile("s_waitcnt vmcnt(0)" ::: "memory");
        __builtin_amdgcn_s_barrier(); asm volatile("" ::: "memory");
    }
    {
        const int st0 = ((NP - 1) & 1) * 2;
        AT_TILE(st0);
        if (sub >= 2) AT_TILE(st0 + 1);
        AT_PV(vfb, pfn);
        __builtin_amdgcn_s_barrier(); asm volatile("" ::: "memory");
    }
    lsum += ls;
#undef AT_SB
#undef AT_KLD
#undef AT_QK
#undef AT_EXPBLK
#undef AT_PV
#undef AT_VLD
#undef AT_TILE
#undef AT_DMA
    lsum += __shfl_xor(lsum, 32);
    const float rl = 1.0f / lsum;
    LAS float* xch = (LAS float*)lds;
    if (map == 1) {
#pragma unroll
        for (int dt = 0; dt < 4; ++dt)
#pragma unroll
            for (int i = 0; i < 16; ++i) xch[((sub * 4 + dt) * 16 + i) * 64 + lane] = o[dt][i] * rl;
    }
    __syncthreads();
    if (map == 0) {
        float ss = 0.f;
#pragma unroll
        for (int dt = 0; dt < 4; ++dt)
#pragma unroll
            for (int i = 0; i < 16; ++i) { const float v = o[dt][i] * rl - lam * xch[((sub * 4 + dt) * 16 + i) * 64 + lane]; o[dt][i] = v; ss += v * v; }
        ss += __shfl_xor(ss, 32);
        const float rn = __builtin_amdgcn_rsqf(ss * (1.0f / 128.0f) + EPS) * 0.8f;
        LAS unsigned char* stg = lds + 65536 + sub * (32 * 272);
#pragma unroll
        for (int dt = 0; dt < 4; ++dt)
#pragma unroll
            for (int g4 = 0; g4 < 4; ++g4) { const int dv0 = 32 * dt + 8 * g4 + 4 * hh; const f32x4 gv = *(const f32x4*)(g_out + dv0);
                u32x2 w; w.x = pk2(o[dt][4 * g4] * rn * gv[0], o[dt][4 * g4 + 1] * rn * gv[1]); w.y = pk2(o[dt][4 * g4 + 2] * rn * gv[2], o[dt][4 * g4 + 3] * rn * gv[3]);
                *(LAS u32x2*)(stg + r * 272 + dv0 * 2) = w; }
        asm volatile("s_waitcnt lgkmcnt(0)" ::: "memory");
        bf16_t* op = OD + (tok0 + qb * 128 + sub * 32) * 512 + h * 128;
#pragma unroll
        for (int i = 0; i < 8; ++i) { const int row = i * 4 + (lane >> 4), ch = lane & 15;
            const u32x4 v = *(const LAS u32x4*)(stg + row * 272 + ch * 16);
            *(u32x4*)(op + (size_t)row * 512 + ch * 8) = v; }
    }
    __syncthreads();
}

__device__ __forceinline__ void gla_item(LAS unsigned char* lds, const bf16_t* __restrict__ GQ, const bf16_t* __restrict__ GK, const float* __restrict__ LA,
                                         const bf16_t* __restrict__ VT, const bf16_t* __restrict__ GR, const float* __restrict__ g_out, bf16_t* __restrict__ OG, int b, int h) {
    constexpr int KP = 144;
    constexpr int O_QF = 0, O_QB = 9216, O_KF = 18432, O_KB = 27648, O_KDT = 36864, O_VT = 46080, O_ST = 64512, O_AL = 82944, O_SEG = 92160, O_DEC = 100352, O_SSQ = 100608, O_GR = 102400, O_OS = 119808, GP = 272;
    const int tid = tid_fresh(), lane = tid & 63, r = lane & 31, hh = lane >> 5;
    const int wid = __builtin_amdgcn_readfirstlane(tid >> 6);
    const int dp = tid & 31, sg = tid >> 5;
    const int dkt = wid >> 2, dvt = wid & 3, lt = wid >> 2;
    LAS f32x2* segtot = (LAS f32x2*)(lds + O_SEG); LAS float* dec = (LAS float*)(lds + O_DEC); LAS float* ssq = (LAS float*)(lds + O_SSQ);
    f32x16 S;
#pragma unroll
    for (int i = 0; i < 16; ++i) S[i] = 0.f;
    const size_t rbase = (size_t)b * SEQ * 256 + (size_t)(4 * sg) * 256 + h * 64 + 2 * dp;
    const bf16_t* vbase0 = VT + ((size_t)b * 1024 + h * 128 + (tid >> 3)) * SEQ + (tid & 7) * 8;
    f32x2 cum[4], la_n[4]; unsigned q_n[4], k_n[4]; u32x4 v_n[2], g_n[2];
    const int goff = (tid >> 4) * 512 + (tid & 15) * 8;
    const bf16_t* gbase0 = GR + (size_t)b * SEQ * 512 + h * 128;
    bf16_t* obase0 = OG + (size_t)b * SEQ * 512 + h * 128;
#pragma unroll
    for (int i = 0; i < 4; ++i) { cum[i] = *(const f32x2*)(LA + rbase + i * 256); la_n[i] = *(const f32x2*)(LA + rbase + 64 * 256 + i * 256);
        q_n[i] = *(const unsigned*)(GQ + rbase + i * 256); k_n[i] = *(const unsigned*)(GK + rbase + i * 256); }
#pragma unroll
    for (int j = 0; j < 2; ++j) { v_n[j] = *(const u32x4*)(vbase0 + (size_t)j * 64 * SEQ); g_n[j] = *(const u32x4*)(gbase0 + goff + j * 32 * 512); }
#pragma unroll
    for (int i = 1; i < 4; ++i) cum[i] += cum[i - 1];
    segtot[sg * 32 + dp] = cum[3];
    __syncthreads();
    for (int n = 0; n < SEQ / 64; ++n) {
        const size_t t0 = (size_t)b * SEQ + 64 * n;
        LAS f32x2* segc = segtot + (n & 1) * 512; LAS f32x2* segn = segtot + ((n + 1) & 1) * 512;
        {
            f32x2 prefix = {0.f, 0.f}, total = {0.f, 0.f};
#pragma unroll 4
            for (int s = 0; s < 16; ++s) { const f32x2 v = segc[s * 32 + dp]; total += v; if (s < sg) prefix += v; }
            f32x2 etot; etot.x = __expf(total.x); etot.y = __expf(total.y);
            float kd0[4], kd1[4];
#pragma unroll
            for (int i = 0; i < 4; ++i) { const f32x2 cm = prefix + cum[i]; f32x2 ep, em; ep.x = __expf(cm.x); ep.y = __expf(cm.y);
                em.x = __builtin_amdgcn_rcpf(ep.x); em.y = __builtin_amdgcn_rcpf(ep.y);
                const float q0 = bf_lo(q_n[i]), q1 = bf_hi(q_n[i]), k0 = bf_lo(k_n[i]), k1 = bf_hi(k_n[i]);
                const int o = (4 * sg + i) * KP + dp * 4;
                *(LAS unsigned*)(lds + O_QF + o) = pk2(q0 * ep.x, q1 * ep.y);
                *(LAS unsigned*)(lds + O_QB + o) = pk2(q0 * em.x, q1 * em.y);
                *(LAS unsigned*)(lds + O_KF + o) = pk2(k0 * em.x, k1 * em.y);
                *(LAS unsigned*)(lds + O_KB + o) = pk2(k0 * ep.x, k1 * ep.y);
                kd0[i] = k0 * (etot.x * em.x); kd1[i] = k1 * (etot.y * em.y); }
            u32x2 w0, w1; w0.x = pk2(kd0[0], kd0[1]); w0.y = pk2(kd0[2], kd0[3]); w1.x = pk2(kd1[0], kd1[1]); w1.y = pk2(kd1[2], kd1[3]);
            *(LAS u32x2*)(lds + O_KDT + (2 * dp) * KP + sg * 8) = w0;
            *(LAS u32x2*)(lds + O_KDT + (2 * dp + 1) * KP + sg * 8) = w1;
            if (sg == 0) { dec[2 * dp] = etot.x; dec[2 * dp + 1] = etot.y; }
#pragma unroll
            for (int j = 0; j < 2; ++j) { const int c = tid + 512 * j; const int ch = c & 7; LAS unsigned char* vp = lds + O_VT + (c >> 3) * KP + ((ch >> 1) * 16 + (ch & 1) * 4) * 2;
                u32x2 lo, hi; lo.x = v_n[j].x; lo.y = v_n[j].y; hi.x = v_n[j].z; hi.y = v_n[j].w; *(LAS u32x2*)vp = lo; *(LAS u32x2*)(vp + 16) = hi; }
            { const int n1 = (n + 1 < SEQ / 64) ? n + 1 : n;
#pragma unroll
              for (int i = 0; i < 4; ++i) { const size_t o1 = rbase + (size_t)n1 * 64 * 256 + i * 256; q_n[i] = *(const unsigned*)(GQ + o1); k_n[i] = *(const unsigned*)(GK + o1); }
#pragma unroll
              for (int j = 0; j < 2; ++j) v_n[j] = *(const u32x4*)(vbase0 + (size_t)j * 64 * SEQ + 64 * n1); }
        }
        __syncthreads();
        if (wid < 4) {
            const int ltile = (wid == 1 || wid == 2) ? 1 : 0, mtile = (wid == 1 || wid == 3) ? 1 : 0;
            const bool needf = (wid != 3), needb = (wid != 2);
            f32x16 af, ab;
#pragma unroll
            for (int i = 0; i < 16; ++i) { af[i] = 0.f; ab[i] = 0.f; }
            const int ko = (32 * mtile + r) * KP + hh * 16, qo = (32 * ltile + r) * KP + hh * 16;
            if (needf) {
#pragma unroll
                for (int s = 0; s < 4; ++s) af = __builtin_amdgcn_mfma_f32_32x32x16_bf16(*(const LAS bf16x8*)(lds + O_KF + ko + s * 32), *(const LAS bf16x8*)(lds + O_QF + qo + s * 32), af, 0, 0, 0);
            }
            if (needb) {
#pragma unroll
                for (int s = 0; s < 4; ++s) ab = __builtin_amdgcn_mfma_f32_32x32x16_bf16(*(const LAS bf16x8*)(lds + O_KB + ko + s * 32), *(const LAS bf16x8*)(lds + O_QB + qo + s * 32), ab, 0, 0, 0);
            }
            const int lg = 32 * ltile + r;
#pragma unroll
            for (int g4 = 0; g4 < 4; ++g4) { float v[4];
#pragma unroll
                for (int j = 0; j < 4; ++j) { const int mg = 32 * mtile + 8 * g4 + 4 * hh + j; v[j] = (lg >= mg) ? af[4 * g4 + j] : ab[4 * g4 + j]; }
                u32x2 w; w.x = pk2(v[0], v[1]); w.y = pk2(v[2], v[3]);
                *(LAS u32x2*)(lds + O_AL + lg * KP + (32 * mtile + 8 * g4 + 4 * hh) * 2) = w; }
        }
#pragma unroll
        for (int g4 = 0; g4 < 4; ++g4) { u32x2 w; w.x = pk2(S[4 * g4], S[4 * g4 + 1]); w.y = pk2(S[4 * g4 + 2], S[4 * g4 + 3]);
            *(LAS u32x2*)(lds + O_ST + (32 * dvt + r) * KP + (32 * dkt + 8 * g4 + 4 * hh) * 2) = w; }
#pragma unroll
        for (int j = 0; j < 2; ++j) { const int c = tid + 512 * j; *(LAS u32x4*)(lds + O_GR + (c >> 4) * GP + (c & 15) * 16) = g_n[j]; }
        { const int n1 = (n + 1 < SEQ / 64) ? n + 1 : n;
#pragma unroll
          for (int j = 0; j < 2; ++j) g_n[j] = *(const u32x4*)(gbase0 + (size_t)n1 * 64 * 512 + goff + j * 32 * 512); }
        if (n > 0) {
#pragma unroll
            for (int j = 0; j < 2; ++j) { const int c = tid + 512 * j; const u32x4 v = *(const LAS u32x4*)(lds + O_OS + (c >> 4) * GP + (c & 15) * 16);
                *(u32x4*)(obase0 + (size_t)(n - 1) * 64 * 512 + goff + j * 32 * 512) = v; }
        }
#pragma unroll
        for (int i = 0; i < 4; ++i) cum[i] = la_n[i];
#pragma unroll
        for (int i = 1; i < 4; ++i) cum[i] += cum[i - 1];
        segn[sg * 32 + dp] = cum[3];
        { const int n2 = (n + 2 < SEQ / 64) ? n + 2 : SEQ / 64 - 1;
#pragma unroll
          for (int i = 0; i < 4; ++i) la_n[i] = *(const f32x2*)(LA + rbase + (size_t)n2 * 64 * 256 + i * 256); }
        __syncthreads();
        f32x16 o;
#pragma unroll
        for (int i = 0; i < 16; ++i) o[i] = 0.f;
        {
            const int vo = (32 * dvt + r) * KP + hh * 16, lo = (32 * lt + r) * KP + hh * 16;
#pragma unroll
            for (int s = 0; s < 4; ++s) o = __builtin_amdgcn_mfma_f32_32x32x16_bf16(*(const LAS bf16x8*)(lds + O_VT + vo + s * 32), *(const LAS bf16x8*)(lds + O_AL + lo + s * 32), o, 0, 0, 0);
#pragma unroll
            for (int s = 0; s < 4; ++s) o = __builtin_amdgcn_mfma_f32_32x32x16_bf16(*(const LAS bf16x8*)(lds + O_ST + vo + s * 32), *(const LAS bf16x8*)(lds + O_QF + lo + s * 32), o, 0, 0, 0);
#pragma unroll
            for (int g4 = 0; g4 < 4; ++g4) { const f32x4 dc = *(const LAS f32x4*)(dec + 32 * dkt + 8 * g4 + 4 * hh);
#pragma unroll
                for (int j = 0; j < 4; ++j) S[4 * g4 + j] *= dc[j]; }
            const int ka = (32 * dkt + r) * KP + hh * 16;
#pragma unroll
            for (int s = 0; s < 4; ++s) S = __builtin_amdgcn_mfma_f32_32x32x16_bf16(*(const LAS bf16x8*)(lds + O_KDT + ka + s * 32), *(const LAS bf16x8*)(lds + O_VT + vo + s * 32), S, 0, 0, 0);
        }
        float ss = 0.f;
#pragma unroll
        for (int i = 0; i < 16; ++i) ss += o[i] * o[i];
        ss += __shfl_xor(ss, 32);
        if (hh == 0) ssq[(lt * 4 + dvt) * 32 + r] = ss;
        __syncthreads();
        {
            const float tot = (ssq[(lt * 4 + 0) * 32 + r] + ssq[(lt * 4 + 1) * 32 + r]) + (ssq[(lt * 4 + 2) * 32 + r] + ssq[(lt * 4 + 3) * 32 + r]);
            const float rn = __builtin_amdgcn_rsqf(tot * (1.0f / 128.0f) + EPS);
#pragma unroll
            for (int g4 = 0; g4 < 4; ++g4) { const int dv0 = 32 * dvt + 8 * g4 + 4 * hh; const int lo_ = (32 * lt + r) * GP + dv0 * 2;
                const u32x2 gt = *(const LAS u32x2*)(lds + O_GR + lo_); const f32x4 gv = *(const f32x4*)(g_out + dv0);
                u32x2 w; w.x = pk2(o[4 * g4] * rn * gv[0] * bf_lo(gt.x), o[4 * g4 + 1] * rn * gv[1] * bf_hi(gt.x));
                w.y = pk2(o[4 * g4 + 2] * rn * gv[2] * bf_lo(gt.y), o[4 * g4 + 3] * rn * gv[3] * bf_hi(gt.y));
                *(LAS u32x2*)(lds + O_OS + lo_) = w; }
        }
    }
    __syncthreads();
#pragma unroll
    for (int j = 0; j < 2; ++j) { const int c = tid + 512 * j; const u32x4 v = *(const LAS u32x4*)(lds + O_OS + (c >> 4) * GP + (c & 15) * 16);
        *(u32x4*)(obase0 + (size_t)(SEQ / 64 - 1) * 64 * 512 + goff + j * 32 * 512) = v; }
    __syncthreads();
}

#define XB_TMO      128
#define XB_XCNT(j)  (256  + 64 * (j))
#define XB_XSUB(j)  (1280 + 64 * (j))
#define XB_XGEN(j)  (2304 + 64 * (j))
#define XB_TOP      3328
#define XB_TOPGEN   3392
#define XCD_BAR_WORDS 3456
#define XB_SPIN_CAP (1u << 18)

__device__ __forceinline__ unsigned xb_ld(unsigned* p)              { return __hip_atomic_load(p, __ATOMIC_RELAXED, __HIP_MEMORY_SCOPE_AGENT); }
__device__ __forceinline__ unsigned xb_add(unsigned* p, unsigned v) { return __hip_atomic_fetch_add(p, v, __ATOMIC_RELAXED, __HIP_MEMORY_SCOPE_AGENT); }
__device__ __forceinline__ unsigned xb_xcc_id() { return (unsigned)__builtin_amdgcn_s_getreg((3 << 11) | 20) & 0xFu; }
#define XB_SPIN(cond, bar) do { unsigned _sp = 0; while (cond) { __builtin_amdgcn_s_sleep(1); \
    if ((++_sp & 255u) == 0u) { if (xb_ld(&(bar)[XB_TMO])) break; if (_sp > XB_SPIN_CAP) { atomicAdd(&(bar)[XB_TMO], 1u); break; } } } } while (0)

struct XcdBarrier {
    unsigned* bar; unsigned x;
    volatile LAS unsigned* st;
};

__device__ __forceinline__ XcdBarrier xcd_barrier_post(unsigned* bar, volatile LAS unsigned* st) {
    XcdBarrier b; b.bar = bar; b.x = xb_xcc_id(); b.st = st;
    if (threadIdx.x == 0) (void)xb_add(&bar[XB_XCNT(b.x)], 1u);
    return b;
}
__device__ __forceinline__ void xcd_barrier_complete(unsigned* bar, unsigned x, unsigned& nloc, unsigned& nx) {
    const unsigned G = gridDim.x * gridDim.y * gridDim.z;
    unsigned sum, cnt, mine, sp = 0u;
    for (;;) {
        sum = 0u; cnt = 0u; mine = 0u;
#pragma unroll
        for (unsigned j = 0; j < 16; ++j) { const unsigned c = xb_ld(&bar[XB_XCNT(j)]); sum += c; cnt += (c > 0u) ? 1u : 0u; mine = (j == x) ? c : mine; }
        if (sum == G) break;
        __builtin_amdgcn_s_sleep(1);
        if ((++sp & 255u) == 0u) { if (xb_ld(&bar[XB_TMO])) break; if (sp > XB_SPIN_CAP) { atomicAdd(&bar[XB_TMO], 1u); break; } }
    }
    nloc = mine > 0u ? mine : 1u; nx = cnt > 0u ? cnt : 1u;
}

__device__ __forceinline__ void xcd_barrier(const XcdBarrier& b) {
    asm volatile("s_waitcnt vmcnt(0)" ::: "memory");
    __syncthreads();
    if (threadIdx.x == 0) {
        unsigned* bar = b.bar;
        __builtin_amdgcn_s_waitcnt(0);
        unsigned nloc = b.st[0], nx = b.st[1];
        if (nloc == 0u) { xcd_barrier_complete(bar, b.x, nloc, nx); b.st[0] = nloc; b.st[1] = nx; }
        const unsigned old = xb_add(&bar[XB_XSUB(b.x)], 1u);
        const unsigned gen = old / nloc;
        if (old + 1u == (gen + 1u) * nloc) {
            __builtin_amdgcn_fence(__ATOMIC_RELEASE, "agent");
            asm volatile("s_waitcnt vmcnt(0)" ::: "memory");
            const unsigned og = xb_add(&bar[XB_TOP], 1u);
            const unsigned tg = og / nx;
            if (og + 1u == (tg + 1u) * nx) xb_add(&bar[XB_TOPGEN], 1u);
            else XB_SPIN(xb_ld(&bar[XB_TOPGEN]) == tg, bar);
            __builtin_amdgcn_fence(__ATOMIC_ACQUIRE, "agent");
            xb_add(&bar[XB_XGEN(b.x)], 1u);
            asm volatile("s_waitcnt vmcnt(0)" ::: "memory");
        } else {
            XB_SPIN(xb_ld(&bar[XB_XGEN(b.x)]) == gen, bar);
            __builtin_amdgcn_fence(__ATOMIC_ACQUIRE, "agent");
            asm volatile("s_waitcnt vmcnt(0)" ::: "memory");
        }
    }
    __syncthreads();
}


constexpr int NPHASE = 9;
#ifndef PROBE_MODE
#define PROBE_MODE 0
#endif
__global__ void __launch_bounds__(512, 2) fwd_kernel(Args args) {
    extern __shared__ __attribute__((aligned(16))) unsigned char lds_raw[];
    LAS unsigned char* lds = (LAS unsigned char*)lds_raw;
    cg::grid_group grid = cg::this_grid();
    const int G = gridDim.x; const int lo = args.ph_lo, hi = args.ph_hi;
    unsigned char* ws = args.ws;
    const float* x = args.in[0];
    float* mod = (float*)(ws + WS_MOD);
    bf16_t* H = (bf16_t*)(ws + WS_H);
#define IN(k) (lo <= (k) && (k) < hi)
    { volatile LAS unsigned* st0 = (volatile LAS unsigned*)(lds + 140016); if (threadIdx.x < 2) st0[threadIdx.x] = 0u; }
    __syncthreads();
    XcdBarrier xbar = xcd_barrier_post((unsigned*)(ws + WS_BAR), (volatile LAS unsigned*)(lds + 140016));
    if (lo < 0) grid.sync();
#define SEAM(k) do { if (IN(k) && IN((k) + 1)) xcd_barrier(xbar); } while (0)
    if (IN(0)) phase0(args, lds, G);
    SEAM(0);
    if (IN(1)) norm_rows(x, args.in[4], mod, 0, DM, H, G);
    SEAM(1);
    if (IN(2)) {
        { pg8::Gemm g{H, H, (const bf16_t*)(ws + WS_WA), (const bf16_t*)(ws + WS_WA), MTOK, NA, DM};
          typedef pg8::StaticOrder<MTOK / 256, NA / 256, 0> SO; SO S; S.init(G, (int)blockIdx.x);
          pg8::EpiInA E{(bf16_t*)(ws + WS_GQ), (bf16_t*)(ws + WS_GK), (bf16_t*)(ws + WS_GR), (bf16_t*)(ws + WS_DQ), (bf16_t*)(ws + WS_DK), (bf16_t*)(ws + WS_G1), (bf16_t*)(ws + WS_G2),
                        (float*)(ws + WS_LA), args.in[7], args.in[9], args.in[10]};
          pg8::gemm_phase<pg8::EpiInA, SO, true, true>(lds, g, S, E); }
        { pg8::Gemm g{(const bf16_t*)(ws + WS_WV), (const bf16_t*)(ws + WS_WV), H, H, 1024, MTOK, DM};
          typedef pg8::StaticOrder<4, MTOK / 256, 0> SO; SO S; S.init(G, (int)blockIdx.x);
          pg8::EpiInV E{(bf16_t*)(ws + WS_VT)};
          pg8::gemm_phase<pg8::EpiInV, SO, true, true>(lds, g, S, E); }
    }
    SEAM(2);
    if (IN(3)) {
        unsigned* qctr = (unsigned*)(ws + WS_MISC) + 8;
        const float lam = ((const float*)(ws + WS_MISC))[1];
        LAS unsigned* slot = (LAS unsigned*)(lds + 140000);
        for (int kq = 0; kq < 8; ++kq) {
            const int xl = ((int)blockIdx.x + kq) & 7;
            for (;;) {
                if (threadIdx.x == 0) *slot = __hip_atomic_fetch_add(qctr + xl, 1u, __ATOMIC_RELAXED, __HIP_MEMORY_SCOPE_AGENT);
                __syncthreads();
                const unsigned item = *slot;
                __syncthreads();
                if (item >= 8u + 256u) break;
                if (item < 8u) { const int bh = xl * 8 + (int)item;
                    gla_item(lds, (const bf16_t*)(ws + WS_GQ), (const bf16_t*)(ws + WS_GK), (const float*)(ws + WS_LA), (const bf16_t*)(ws + WS_VT), (const bf16_t*)(ws + WS_GR),
                             args.in[8], (bf16_t*)(ws + WS_OG), bh >> 2, bh & 3); }
                else { const unsigned a = item - 8u; const int bh = xl * 8 + (int)(a >> 5), qb = 31 - (int)(a & 31);
                    attn_unit(lds, (const bf16_t*)(ws + WS_DQ), (const bf16_t*)(ws + WS_DK), (const bf16_t*)(ws + WS_VT), (bf16_t*)(ws + WS_OD), args.in[15], lam, bh >> 2, bh & 3, qb); }
            }
        }
    }
#if PROBE_MODE == 1
    grid.sync();
    {
        unsigned* qctr = (unsigned*)(ws + WS_MISC) + 2;
        const float lam = ((const float*)(ws + WS_MISC))[1];
        LAS unsigned* slot = (LAS unsigned*)(lds + 140000);
        for (;;) {
            if (threadIdx.x == 0) *slot = __hip_atomic_fetch_add(qctr, 1u, __ATOMIC_RELAXED, __HIP_MEMORY_SCOPE_AGENT);
            __syncthreads();
            const unsigned item = *slot;
            __syncthreads();
            if (item >= 64u + 2048u) break;
            if (item < 64u) gla_item(lds, (const bf16_t*)(ws + WS_GQ), (const bf16_t*)(ws + WS_GK), (const float*)(ws + WS_LA), (const bf16_t*)(ws + WS_VT), (const bf16_t*)(ws + WS_GR),
                                     args.in[8], (bf16_t*)(ws + WS_OG), (int)(item >> 2), (int)(item & 3));
            else { const unsigned a = item - 64u; const int qb = 31 - (int)(a >> 6), bh = (int)(a & 63);
                attn_unit(lds, (const bf16_t*)(ws + WS_DQ), (const bf16_t*)(ws + WS_DK), (const bf16_t*)(ws + WS_VT), (bf16_t*)(ws + WS_OD), args.in[15], lam, bh >> 2, bh & 3, qb); }
        }
    }
#elif PROBE_MODE == 2
    grid.sync();
    if (blockIdx.x < 64) gla_item(lds, (const bf16_t*)(ws + WS_GQ), (const bf16_t*)(ws + WS_GK), (const float*)(ws + WS_LA), (const bf16_t*)(ws + WS_VT), (const bf16_t*)(ws + WS_GR),
                                     args.in[8], (bf16_t*)(ws + WS_OG), (int)(blockIdx.x >> 2), (int)(blockIdx.x & 3));
#endif
    SEAM(3);
    if (IN(4)) {
        pg8::Gemm g{(const bf16_t*)(ws + WS_OG), (const bf16_t*)(ws + WS_OD), (const bf16_t*)(ws + WS_WBG), (const bf16_t*)(ws + WS_WBD), MTOK, DM, 512};
        typedef pg8::StaticOrder<MTOK / 256, DM / 256, 1> SO; SO S; S.init(G, (int)blockIdx.x);
        pg8::EpiMerge E{(const bf16_t*)(ws + WS_G1), (const bf16_t*)(ws + WS_G2), (bf16_t*)(ws + WS_MIX)};
        pg8::gemm_phase<pg8::EpiMerge, SO, true, true>(lds, g, S, E);
    }
    SEAM(4);
    if (IN(5)) {
        pg8::Gemm g{(const bf16_t*)(ws + WS_MIX), (const bf16_t*)(ws + WS_MIX), (const bf16_t*)(ws + WS_WO), (const bf16_t*)(ws + WS_WO), MTOK, DM, DM};
        typedef pg8::StaticOrder<MTOK / 256, DM / 256, 0> SO; SO S; S.init(G, (int)blockIdx.x);
        typedef pg8::EpiResid<false, true> EP; EP E{x, (void*)(ws + WS_X1B), mod + 2 * DM};
        pg8::gemm_phase<EP, SO, true, true>(lds, g, S, E);
    }
    SEAM(5);
    if (IN(6)) norm_rows_bf((const bf16_t*)(ws + WS_X1B), args.in[19], mod, 3 * DM, 4 * DM, H, G);
    SEAM(6);
    if (IN(7)) {
        pg8::Gemm g{H, H, (const bf16_t*)(ws + WS_WF1), (const bf16_t*)(ws + WS_WF1), MTOK, 2 * FFH, DM};
        typedef pg8::StaticOrder<MTOK / 256, 2 * FFH / 256, 0> SO; SO S; S.init(G, (int)blockIdx.x);
        pg8::EpiSwiglu E{(bf16_t*)(ws + WS_ACT)};
        pg8::gemm_phase<pg8::EpiSwiglu, SO, true, true>(lds, g, S, E);
    }
    SEAM(7);
    if (IN(8)) {
        pg8::Gemm g{(const bf16_t*)(ws + WS_ACT), (const bf16_t*)(ws + WS_ACT), (const bf16_t*)(ws + WS_WF2), (const bf16_t*)(ws + WS_WF2), MTOK, DM, FFH};
        typedef pg8::StaticOrder<MTOK / 256, DM / 256, 0> SO; SO S; S.init(G, (int)blockIdx.x);
        typedef pg8::EpiResid<true, false> EP; EP E{(const void*)(ws + WS_X1B), (void*)args.out, mod + 5 * DM};
        pg8::gemm_phase<EP, SO, true, true>(lds, g, S, E);
    }
#undef IN
#undef SEAM
}

#ifndef MK_MULTI
#define MK_MULTI 0
#endif

extern "C" void kernel_launch(void* const* d_in, const int* in_sizes, int n_in, void* d_out, int out_size, void* d_ws, size_t ws_size, hipStream_t stream) {
    static int grid = 0;
    if (grid == 0) {
        if (n_in != 22 || out_size != MTOK * DM || ws_size < WS_END) { fprintf(stderr, "kernel_launch: unexpected shapes (n_in %d out %d ws %zu)\n", n_in, out_size, ws_size); grid = -1; return; }
        int dev = 0, cus = 0, per_cu = 0;
        (void)hipGetDevice(&dev);
        (void)hipDeviceGetAttribute(&cus, hipDeviceAttributeMultiprocessorCount, dev);
        if (hipFuncSetAttribute((const void*)fwd_kernel, hipFuncAttributeMaxDynamicSharedMemorySize, LDS_BYTES) != hipSuccess) { fprintf(stderr, "kernel_launch: hipFuncSetAttribute failed\n"); grid = -1; return; }
        if (hipOccupancyMaxActiveBlocksPerMultiprocessor(&per_cu, (const void*)fwd_kernel, 512, LDS_BYTES) != hipSuccess || per_cu < 1) { fprintf(stderr, "kernel_launch: occupancy query says %d\n", per_cu); per_cu = 1; }
        (void)hipGetLastError();
        grid = cus * 1;
        fprintf(stderr, "kernel_launch: grid %d (cus %d per_cu %d)\n", grid, cus, per_cu);
    }
    if (grid < 0) return;
    Args a{};
    for (int i = 0; i < 22; ++i) a.in[i] = (const float*)d_in[i];
    a.out = (float*)d_out; a.ws = (unsigned char*)d_ws;
#if MK_MULTI
    for (int p = 0; p < NPHASE; ++p) { a.ph_lo = p; a.ph_hi = p + 1; hipLaunchKernelGGL(fwd_kernel, dim3(grid), dim3(512), LDS_BYTES, stream, a); }
#else
    a.ph_lo = 0; a.ph_hi = NPHASE;
    (void)hipMemsetAsync((unsigned char*)d_ws + WS_BAR, 0, 16384, stream);
    void* kargs[] = {&a};
    hipError_t e = hipLaunchCooperativeKernel((const void*)fwd_kernel, dim3(grid), dim3(512), kargs, LDS_BYTES, stream);
    if (e != hipSuccess) fprintf(stderr, "kernel_launch: cooperative launch failed: %s (grid %d)\n", hipGetErrorString(e), grid);
#endif
}
```
